# Optimizing an MI355X kernel written in HIP

```python
import jax
import jax.numpy as jnp
from jax import lax
import numpy as np

D_MODEL = 1024
BATCH = 8
SEQ = 2048
DEPTH = 2
DEC_BATCH = 32
DEC_SEQ = 4
PAST_LEN = 16384
PAGE_SIZE = 128

N_EVEN = (DEPTH + 1) // 2
N_ODD = DEPTH // 2
POOL_DIM = D_MODEL // 2
POOL_WINDOWS = (2, 4, 8, 16)
POOL_GROUP = POOL_DIM // len(POOL_WINDOWS)
POOL_HIST = max(POOL_WINDOWS) - 1
RET_HEADS = 4
RET_DK = 128
RET_DV = 128
RET_CHUNK = 128
EVEN_IN = POOL_DIM + 2 * RET_HEADS * RET_DK + 2 * RET_HEADS * RET_DV
EVEN_OUT = POOL_DIM + RET_HEADS * RET_DV
MLA_HEADS = 8
QK_NOPE = 128
QK_ROPE = 64
V_DIM = 128
Q_LORA = 512
KV_LORA = 256
MLA_SCALE = (QK_NOPE + QK_ROPE) ** -0.5
ATTN_Q_BLOCK = 128
D_FF = 2816
CONV_W = 3
ALPHA = (2.0 * DEPTH) ** 0.25
BETA = (8.0 * DEPTH) ** -0.25
ROPE_THETA = 10000.0
LN_EPS = 1e-5
RMS_EPS = 1e-6
GN_EPS = 1e-6

kernel_name = 'hybrid_pool_retention_mla_convffn_step'

F32 = jnp.float32


def layer_norm(x, g, b):
    xf = x.astype(F32)
    mu = jnp.mean(xf, axis=-1, keepdims=True)
    var = jnp.mean(jnp.square(xf - mu), axis=-1, keepdims=True)
    return ((xf - mu) * lax.rsqrt(var + LN_EPS) * g.astype(F32) + b.astype(F32)).astype(x.dtype)


def rms_norm(x, g):
    xf = x.astype(F32)
    ms = jnp.mean(jnp.square(xf), axis=-1, keepdims=True)
    return (xf * lax.rsqrt(ms + RMS_EPS) * g.astype(F32)).astype(x.dtype)


def rope(x, pos):
    half = x.shape[-1] // 2
    inv_freq = ROPE_THETA ** (-jnp.arange(half, dtype=F32) / half)
    ang = pos[:, None] * inv_freq[None, :]
    shape = (pos.shape[0],) + (1,) * (x.ndim - 3) + (half,)
    cos = jnp.cos(ang).reshape(shape)
    sin = jnp.sin(ang).reshape(shape)
    xf = x.astype(F32)
    x1, x2 = xf[..., :half], xf[..., half:]
    return jnp.concatenate([x1 * cos - x2 * sin, x2 * cos + x1 * sin], axis=-1).astype(x.dtype)


def pool_mixer(u, hist, pos, pool_w, pool_scale):
    B, L, _ = u.shape
    u_ext = jnp.concatenate([hist.astype(u.dtype), u], axis=1)
    cs = jnp.cumsum(u_ext.astype(F32), axis=1)
    cs = jnp.concatenate([jnp.zeros_like(cs[:, :1]), cs], axis=1)
    end = cs[:, POOL_HIST + 1:]
    outs = []
    for gi, w in enumerate(POOL_WINDOWS):
        sl = slice(gi * POOL_GROUP, (gi + 1) * POOL_GROUP)
        start = cs[:, POOL_HIST + 1 - w:POOL_HIST + 1 - w + L, sl]
        cnt = jnp.minimum(float(w), pos + 1.0)[None, :, None]
        outs.append((end[..., sl] - start) / cnt - u[..., sl].astype(F32))
    pooled = jnp.stack(outs, axis=2).astype(u.dtype)
    mixed = jnp.einsum('blgc,gcd->blgd', pooled, pool_w).reshape(B, L, POOL_DIM)
    return mixed * pool_scale, u_ext[:, -POOL_HIST:]


def retention_chunk(q, k, v, S, log_gamma):
    C = q.shape[1]
    idx = jnp.arange(C, dtype=F32)
    diff = idx[:, None] - idx[None, :]
    decay = jnp.where(diff >= 0, jnp.exp(jnp.maximum(diff, 0.0)[None] * log_gamma[:, None, None]), 0.0).astype(q.dtype)
    scores = jnp.einsum('blhk,bmhk->bhlm', q, k) * decay
    o = jnp.einsum('bhlm,bmhv->blhv', scores, v)
    q_dec = jnp.exp((idx + 1.0)[:, None] * log_gamma[None, :]).astype(q.dtype)
    o = o + jnp.einsum('blhk,bhkv->blhv', q * q_dec[None, :, :, None], S)
    k_dec = jnp.exp((C - 1.0 - idx)[:, None] * log_gamma[None, :]).astype(q.dtype)
    S_new = jnp.exp(C * log_gamma)[None, :, None, None].astype(S.dtype) * S + jnp.einsum('blhk,blhv->bhkv', k * k_dec[None, :, :, None], v)
    return o, S_new.astype(S.dtype)


def retention(q, k, v, S0, log_gamma):
    B, L = q.shape[:2]
    C = RET_CHUNK if L % RET_CHUNK == 0 else L
    nc = L // C

    def to_chunks(t):
        return jnp.moveaxis(t.reshape((B, nc, C) + t.shape[2:]), 1, 0)

    def step(S, blk):
        qc, kc, vc = blk
        o, S = retention_chunk(qc, kc, vc, S, log_gamma)
        return S, o

    S, o = lax.scan(step, S0, (to_chunks(q), to_chunks(k), to_chunks(v)))
    o = jnp.moveaxis(o, 0, 1).reshape(B, L, RET_HEADS, RET_DV)
    return o, S


def even_mixer(x, pos, pool_hist, ret_state, w_in, pool_w, pool_scale, gn_g, w_o):
    B, L, _ = x.shape
    h = x @ w_in
    qk = RET_HEADS * RET_DK
    vd = RET_HEADS * RET_DV
    o0 = POOL_DIM
    u = h[..., :o0]
    q = h[..., o0:o0 + qk].reshape(B, L, RET_HEADS, RET_DK)
    k = h[..., o0 + qk:o0 + 2 * qk].reshape(B, L, RET_HEADS, RET_DK)
    v = h[..., o0 + 2 * qk:o0 + 2 * qk + vd].reshape(B, L, RET_HEADS, RET_DV)
    g = h[..., o0 + 2 * qk + vd:]
    pool_out, pool_hist_new = pool_mixer(u, pool_hist, pos, pool_w, pool_scale)
    q = rope(q, pos)
    k = rope(k, pos) * (RET_DK ** -0.5)
    log_gamma = jnp.log(1.0 - 2.0 ** (-5.0 - jnp.arange(RET_HEADS, dtype=F32)))
    o, S = retention(q, k, v, ret_state.astype(x.dtype), log_gamma)
    of = o.astype(F32)
    mu = jnp.mean(of, axis=-1, keepdims=True)
    var = jnp.mean(jnp.square(of - mu), axis=-1, keepdims=True)
    on = (of - mu) * lax.rsqrt(var + GN_EPS) * gn_g.astype(F32).reshape(RET_HEADS, RET_DV)
    ret_out = (jax.nn.silu(g.astype(F32)) * on.reshape(B, L, vd)).astype(x.dtype)
    y = jnp.concatenate([pool_out.astype(x.dtype), ret_out], axis=-1) @ w_o
    return y, pool_hist_new, S


def mla_project(x, pos, w_dq, q_norm_g, w_uq, w_dkv, kv_norm_g):
    B, L, _ = x.shape
    q = (rms_norm(x @ w_dq, q_norm_g) @ w_uq).reshape(B, L, MLA_HEADS, QK_NOPE + QK_ROPE)
    q_nope = q[..., :QK_NOPE]
    q_pe = rope(q[..., QK_NOPE:], pos)
    kv = x @ w_dkv
    c_kv = rms_norm(kv[..., :KV_LORA], kv_norm_g)
    k_pe = rope(kv[..., KV_LORA:], pos)
    return q_nope, q_pe, c_kv, k_pe


def mla_prompt(x, pos, w_dq, q_norm_g, w_uq, w_dkv, kv_norm_g, w_uk, w_uv, w_o):
    B, L, _ = x.shape
    q_nope, q_pe, c_kv, k_pe = mla_project(x, pos, w_dq, q_norm_g, w_uq, w_dkv, kv_norm_g)
    k_nope = jnp.einsum('bsc,chd->bshd', c_kv, w_uk)
    v = jnp.einsum('bsc,chd->bshd', c_kv, w_uv)
    QB = ATTN_Q_BLOCK if L % ATTN_Q_BLOCK == 0 else L
    nb = L // QB
    key_pos = jnp.arange(L)

    def to_blocks(t):
        return jnp.moveaxis(t.reshape((B, nb, QB) + t.shape[2:]), 1, 0)

    def block(args):
        qn, qp, i = args
        s = jnp.einsum('bqhd,bkhd->bhqk', qn, k_nope) + jnp.einsum('bqhr,bkr->bhqk', qp, k_pe)
        s = s.astype(F32) * MLA_SCALE
        q_pos = i * QB + jnp.arange(QB)
        s = jnp.where(key_pos[None, :] <= q_pos[:, None], s, -jnp.inf)
        p = jax.nn.softmax(s, axis=-1).astype(v.dtype)
        return jnp.einsum('bhqk,bkhd->bqhd', p, v)

    o = lax.map(block, (to_blocks(q_nope), to_blocks(q_pe), jnp.arange(nb)))
    o = jnp.moveaxis(o, 0, 1).reshape(B, L, MLA_HEADS * V_DIM)
    return o @ w_o, c_kv, k_pe


def mla_sample(x, pos, cache_ckv, cache_kpe, layer_idx, page_table, w_dq, q_norm_g, w_uq, w_dkv, kv_norm_g, w_uk, w_uv, w_o):
    B, L, _ = x.shape
    q_nope, q_pe, c_kv, k_pe = mla_project(x, pos, w_dq, q_norm_g, w_uq, w_dkv, kv_norm_g)
    n_pages = page_table.shape[1]
    P = n_pages * PAGE_SIZE
    ckv_past = cache_ckv[layer_idx, page_table].reshape(B, P, KV_LORA).astype(x.dtype)
    kpe_past = cache_kpe[layer_idx, page_table].reshape(B, P, QK_ROPE).astype(x.dtype)
    q_lat = jnp.einsum('bqhd,chd->bqhc', q_nope, w_uk)
    s_past = jnp.einsum('bqhc,bkc->bhqk', q_lat, ckv_past) + jnp.einsum('bqhr,bkr->bhqk', q_pe, kpe_past)
    s_new = jnp.einsum('bqhc,bkc->bhqk', q_lat, c_kv) + jnp.einsum('bqhr,bkr->bhqk', q_pe, k_pe)
    s = jnp.concatenate([s_past, s_new], axis=-1).astype(F32) * MLA_SCALE
    causal = jnp.arange(L)[None, :] <= jnp.arange(L)[:, None]
    mask = jnp.concatenate([jnp.ones((L, P), dtype=bool), causal], axis=-1)
    s = jnp.where(mask, s, -jnp.inf)
    p = jax.nn.softmax(s, axis=-1).astype(x.dtype)
    o_lat = jnp.einsum('bhqk,bkc->bqhc', p[..., :P], ckv_past) + jnp.einsum('bhqk,bkc->bqhc', p[..., P:], c_kv)
    o = jnp.einsum('bqhc,chd->bqhd', o_lat, w_uv).reshape(B, L, MLA_HEADS * V_DIM)
    return o @ w_o, c_kv, k_pe


def conv_ffn(x, hist, w_up, conv_w, conv_b, w_down):
    L = x.shape[1]
    h = x @ w_up
    a, b = h[..., :D_FF], h[..., D_FF:]
    a_ext = jnp.concatenate([hist.astype(a.dtype), a], axis=1)
    conv = conv_b
    for j in range(CONV_W):
        conv = conv + conv_w[j] * a_ext[:, j:j + L]
    y = (jax.nn.silu(conv) * b) @ w_down
    return y, a_ext[:, L:]


def setup_inputs(seed: int = 0) -> dict:
    key = jax.random.key(seed)
    ks = jax.random.split(key, 40)

    def nrm(i, shape, scale):
        return jax.random.normal(ks[i], shape, F32) * scale

    n_pages = PAST_LEN // PAGE_SIZE
    n_pool = (DEC_BATCH * n_pages * 5) // 4
    page_table = jax.random.permutation(ks[0], n_pool)[:DEC_BATCH * n_pages].reshape(DEC_BATCH, n_pages).astype(jnp.int32)
    return {
        'x_prompt': nrm(1, (BATCH, SEQ, D_MODEL), 1.0),
        'x_sample': nrm(2, (DEC_BATCH, DEC_SEQ, D_MODEL), 1.0),
        'state_pool': nrm(3, (N_EVEN, DEC_BATCH, POOL_HIST, POOL_DIM), 1.0),
        'state_ret': nrm(4, (N_EVEN, DEC_BATCH, RET_HEADS, RET_DK, RET_DV), 0.3),
        'cache_ckv': nrm(5, (N_ODD, n_pool, PAGE_SIZE, KV_LORA), 1.0),
        'cache_kpe': nrm(6, (N_ODD, n_pool, PAGE_SIZE, QK_ROPE), 1.0),
        'state_conv': nrm(7, (DEPTH, DEC_BATCH, CONV_W - 1, D_FF), 1.0),
        'page_table': page_table,
        'w_in_even': nrm(8, (N_EVEN, D_MODEL, EVEN_IN), D_MODEL ** -0.5),
        'pool_w': nrm(9, (N_EVEN, len(POOL_WINDOWS), POOL_GROUP, POOL_GROUP), POOL_GROUP ** -0.5),
        'pool_scale': 1.0 + nrm(10, (N_EVEN, POOL_DIM), 0.1),
        'ret_gn_g': 1.0 + nrm(11, (N_EVEN, RET_HEADS * RET_DV), 0.1),
        'w_o_even': nrm(12, (N_EVEN, EVEN_OUT, D_MODEL), EVEN_OUT ** -0.5 * BETA),
        'w_dq': nrm(13, (N_ODD, D_MODEL, Q_LORA), D_MODEL ** -0.5),
        'q_norm_g': 1.0 + nrm(14, (N_ODD, Q_LORA), 0.1),
        'w_uq': nrm(15, (N_ODD, Q_LORA, MLA_HEADS * (QK_NOPE + QK_ROPE)), Q_LORA ** -0.5),
        'w_dkv': nrm(16, (N_ODD, D_MODEL, KV_LORA + QK_ROPE), D_MODEL ** -0.5),
        'kv_norm_g': 1.0 + nrm(17, (N_ODD, KV_LORA), 0.1),
        'w_uk': nrm(18, (N_ODD, KV_LORA, MLA_HEADS, QK_NOPE), KV_LORA ** -0.5),
        'w_uv': nrm(19, (N_ODD, KV_LORA, MLA_HEADS, V_DIM), KV_LORA ** -0.5),
        'w_o_mla': nrm(20, (N_ODD, MLA_HEADS * V_DIM, D_MODEL), (MLA_HEADS * V_DIM) ** -0.5 * BETA),
        'w_up': nrm(21, (DEPTH, D_MODEL, 2 * D_FF), D_MODEL ** -0.5),
        'conv_w': nrm(22, (DEPTH, CONV_W, D_FF), 0.5),
        'conv_b': nrm(23, (DEPTH, D_FF), 0.02),
        'w_down': nrm(24, (DEPTH, D_FF, D_MODEL), D_FF ** -0.5 * BETA),
        'ln_mix_g': 1.0 + nrm(25, (DEPTH, D_MODEL), 0.05),
        'ln_mix_b': nrm(26, (DEPTH, D_MODEL), 0.02),
        'ln_ffn_g': 1.0 + nrm(27, (DEPTH, D_MODEL), 0.05),
        'ln_ffn_b': nrm(28, (DEPTH, D_MODEL), 0.02),
    }


def reference(x_prompt, x_sample, state_pool, state_ret, cache_ckv, cache_kpe, state_conv, page_table,
              w_in_even, pool_w, pool_scale, ret_gn_g, w_o_even,
              w_dq, q_norm_g, w_uq, w_dkv, kv_norm_g, w_uk, w_uv, w_o_mla,
              w_up, conv_w, conv_b, w_down, ln_mix_g, ln_mix_b, ln_ffn_g, ln_ffn_b):
    xp, xs = x_prompt, x_sample
    Bp, Lp, _ = xp.shape
    past_len = page_table.shape[1] * PAGE_SIZE
    pos_p = jnp.arange(Lp, dtype=F32)
    pos_s = past_len + jnp.arange(xs.shape[1], dtype=F32)
    pool_p, pool_s, ret_p, ret_s = [], [], [], []
    ckv_p, ckv_s, kpe_p, kpe_s = [], [], [], []
    conv_p, conv_s = [], []
    for layer in range(DEPTH):
        if layer % 2 == 0:
            e = layer // 2
            hist0 = jnp.zeros((Bp, POOL_HIST, POOL_DIM), xp.dtype)
            S0 = jnp.zeros((Bp, RET_HEADS, RET_DK, RET_DV), xp.dtype)
            mp, hp, sp = even_mixer(xp, pos_p, hist0, S0, w_in_even[e], pool_w[e], pool_scale[e], ret_gn_g[e], w_o_even[e])
            ms, hs, ss = even_mixer(xs, pos_s, state_pool[e], state_ret[e], w_in_even[e], pool_w[e], pool_scale[e], ret_gn_g[e], w_o_even[e])
            pool_p.append(hp)
            pool_s.append(hs)
            ret_p.append(sp)
            ret_s.append(ss)
        else:
            o = layer // 2
            mp, cp, kp = mla_prompt(xp, pos_p, w_dq[o], q_norm_g[o], w_uq[o], w_dkv[o], kv_norm_g[o], w_uk[o], w_uv[o], w_o_mla[o])
            ms, cs, ksmp = mla_sample(xs, pos_s, cache_ckv, cache_kpe, o, page_table, w_dq[o], q_norm_g[o], w_uq[o], w_dkv[o], kv_norm_g[o], w_uk[o], w_uv[o], w_o_mla[o])
            ckv_p.append(cp)
            ckv_s.append(cs)
            kpe_p.append(kp)
            kpe_s.append(ksmp)
        xp = layer_norm(ALPHA * xp + mp, ln_mix_g[layer], ln_mix_b[layer])
        xs = layer_norm(ALPHA * xs + ms, ln_mix_g[layer], ln_mix_b[layer])
        conv0 = jnp.zeros((Bp, CONV_W - 1, D_FF), xp.dtype)
        fp, hcp = conv_ffn(xp, conv0, w_up[layer], conv_w[layer], conv_b[layer], w_down[layer])
        fs, hcs = conv_ffn(xs, state_conv[layer], w_up[layer], conv_w[layer], conv_b[layer], w_down[layer])
        conv_p.append(hcp)
        conv_s.append(hcs)
        xp = layer_norm(ALPHA * xp + fp, ln_ffn_g[layer], ln_ffn_b[layer])
        xs = layer_norm(ALPHA * xs + fs, ln_ffn_g[layer], ln_ffn_b[layer])
    return (xp, xs,
            jnp.stack(pool_p), jnp.stack(pool_s),
            jnp.stack(ret_p), jnp.stack(ret_s),
            jnp.stack(ckv_p), jnp.stack(ckv_s),
            jnp.stack(kpe_p), jnp.stack(kpe_s),
            jnp.stack(conv_p), jnp.stack(conv_s))
```

```cpp
#include <hip/hip_runtime.h>
#include <hip/hip_cooperative_groups.h>
#include <cstdio>
#include <cstdint>
namespace cg = cooperative_groups;

#define LAS __attribute__((address_space(3)))
typedef unsigned short bf16_t;
typedef short bf16x8 __attribute__((ext_vector_type(8)));
typedef short s16x4 __attribute__((ext_vector_type(4)));
typedef float f32x4 __attribute__((ext_vector_type(4)));
typedef float f32x2 __attribute__((ext_vector_type(2)));
typedef float f32x16 __attribute__((ext_vector_type(16)));
typedef unsigned u32x4 __attribute__((ext_vector_type(4)));
typedef unsigned u32x2 __attribute__((ext_vector_type(2)));
typedef __bf16 bf16x2_t __attribute__((ext_vector_type(2)));

__device__ __forceinline__ unsigned pk2(float lo, float hi) { f32x2 v = {lo, hi}; bf16x2_t b = __builtin_convertvector(v, bf16x2_t); return __builtin_bit_cast(unsigned, b); }
__device__ __forceinline__ float bf_lo(unsigned w) { return __uint_as_float(w << 16); }
__device__ __forceinline__ float bf_hi(unsigned w) { return __uint_as_float(w & 0xffff0000u); }
__device__ __forceinline__ float bf2f(bf16_t h) { return __uint_as_float(((unsigned)h) << 16); }
__device__ __forceinline__ bf16_t f2bf(float f) { return (bf16_t)(pk2(f, 0.f) & 0xffffu); }
__device__ __forceinline__ float wave_sum(float v) {
#pragma unroll
    for (int o = 1; o < 64; o <<= 1) v += __shfl_xor(v, o);
    return v;
}
__device__ __forceinline__ float silu_f(float x) { return x / (1.0f + __expf(-x)); }

constexpr int DM = 1024, NB = 8, SEQ = 2048, DB = 32, DS = 4, PAST = 16384, PAGE = 128, NPG = PAST / PAGE;
constexpr int MPR = NB * SEQ;
constexpr int MS = DB * DS;
constexpr int MV = MPR + MS;
constexpr int MP = 65 * 256;
constexpr int POOLD = 512, HIST = 15, RH = 4, RD = 128;
constexpr int EIN = 2560, FF = 2816;
constexpr int MH = 8, NOPE = 128, ROPE = 64, VD = 128, QL = 512, KVL = 256, QKD = NOPE + ROPE;
constexpr float ALPHA = 1.4142135623730951f;
constexpr float LN_EPS = 1e-5f, RMS_EPS = 1e-6f, GN_EPS = 1e-6f;
constexpr float LOG2E = 1.4426950408889634f;
constexpr float QSCALE = 0.07216878364870322f * LOG2E;
constexpr int NPOS = SEQ + DS;

namespace pg8 {
constexpr int BM = 256, BK = 64, HALF = 128, HTB = HALF * BK * 2, STAGE_BYTES = 8 * HTB, NXCD = 8, WGM = 8;
__host__ __device__ __forceinline__ int lds_byte(int r, int c) { const int st = (r >> 4) * 2 + (c >> 5), rr = r & 15, cc = c & 31, ob = rr * 64 + cc * 2; return st * 1024 + (ob ^ (((ob >> 9) & 1) << 5)); }
__host__ __device__ __forceinline__ void stage_rc(int b, int& R, int& C) { const int st = b / 1024, sb = b % 1024, swz = sb ^ (((sb >> 9) & 1) << 5); R = (st >> 1) * 16 + swz / 64; C = (st & 1) * 32 + (swz % 64) / 2; }

struct Unit { int pm, pn; };
struct Gemm { const bf16_t* A; const bf16_t* Bt; int lda, ldb, M, N, K; };

struct StaticOrder {
    int nM, nN, nwg, G, c;
    __host__ __device__ void init(int M, int N, int G_, int c_) { nM = M / BM; nN = N / BM; nwg = nM * nN; G = G_; c = c_; }
    __host__ __device__ bool next(int i, Unit& u) const {
        const long L = (long)i * G + c; if (L >= nwg) return false;
        int wgid = (int)L; { const int q = nwg / NXCD, r = nwg % NXCD, xcd = wgid % NXCD, off = wgid / NXCD; wgid = (xcd < r ? xcd * (q + 1) : r * (q + 1) + (xcd - r) * q) + off; }
        const int nig = WGM * nN, gid = wgid / nig, fm = gid * WGM, gsz = (nM - fm) < WGM ? (nM - fm) : WGM;
        u.pm = fm + ((wgid % nig) % gsz); u.pn = (wgid % nig) / gsz; return true;
    }
};

template <class Epi, bool ALIGN_EPI = true>
__device__ __forceinline__ void gemm_phase(LAS unsigned char* lds, const Gemm g, const StaticOrder& S, const Epi& E) {
    const int tid = threadIdx.x, wid = __builtin_amdgcn_readfirstlane(tid >> 6), lane = tid & 63, wr = wid >> 2, wc = wid & 3, fr = lane & 15, fq = lane >> 4;
    const int K = g.K, nt = K / BK;
    unsigned voffA[2], voffB[2];
#pragma unroll
    for (int i = 0; i < 2; ++i) { int R, C; stage_rc(tid * 16 + i * 8192, R, C);
        voffA[i] = (unsigned)(R * g.lda + C) * 2u; voffB[i] = (unsigned)(R * g.ldb + C) * 2u; }
    const size_t kstep = (size_t)(BK * 2);
    const size_t hstepA = (size_t)HALF * g.lda * 2, hstepB = (size_t)HALF * g.ldb * 2;
    const unsigned ldsw = (unsigned)wid * 1024u;
    const int aoff = lds_byte(wr * 64 + fr, fq * 8), boff = lds_byte(wc * 32 + fr, fq * 8);
#define PG8_SA(b, h) (((b) * 2 + (h)) * HTB)
#define PG8_SB(b, h) ((4 + (b) * 2 + (h)) * HTB)
#define PG8_STAGE(bufoff, gbase, voff) do { _Pragma("unroll") for (int _i = 0; _i < 2; ++_i) \
        __builtin_amdgcn_global_load_lds((const unsigned*)((const char*)(gbase) + (voff)[_i]), (LAS unsigned*)(lds + (bufoff) + ldsw + _i * 8192), 16, 0, 0); } while (0)
#define PG8_LDA(dst, b, h) do { _Pragma("unroll") for (int m = 0; m < 4; ++m) _Pragma("unroll") for (int k = 0; k < 2; ++k) dst[m][k] = *(const LAS bf16x8*)(lds + PG8_SA(b, h) + aoff + m * 2048 + k * 1024); } while (0)
#define PG8_LDB(dst, b, h) do { _Pragma("unroll") for (int n = 0; n < 2; ++n) _Pragma("unroll") for (int k = 0; k < 2; ++k) dst[n][k] = *(const LAS bf16x8*)(lds + PG8_SB(b, h) + boff + n * 2048 + k * 1024); } while (0)
#define PG8_MMA(ai, bj, At, Bt) do { __builtin_amdgcn_s_setprio(1); _Pragma("unroll") for (int m = 0; m < 4; ++m) _Pragma("unroll") for (int n = 0; n < 2; ++n) _Pragma("unroll") for (int k = 0; k < 2; ++k) \
        acc[ai][bj][m][n] = __builtin_amdgcn_mfma_f32_16x16x32_bf16(Bt[n][k], At[m][k], acc[ai][bj][m][n], 0, 0, 0); __builtin_amdgcn_s_setprio(0); } while (0)
#define PG8_WAIT_V(n) asm volatile("s_waitcnt vmcnt(" #n ")" ::: "memory")
#define PG8_WAIT_L(n) asm volatile("s_waitcnt lgkmcnt(" #n ")" ::: "memory")
#define PG8_BAR __builtin_amdgcn_s_barrier()
#define PG8_SCHED __builtin_amdgcn_sched_barrier(0)
    Unit cur, nxt; int ui = 0;
    if (!S.next(0, cur)) return;
    f32x4 acc[2][2][4][2];
#pragma unroll
    for (int a = 0; a < 2; ++a)
#pragma unroll
        for (int b = 0; b < 2; ++b)
#pragma unroll
            for (int m = 0; m < 4; ++m)
#pragma unroll
                for (int n = 0; n < 2; ++n) acc[a][b][m][n] = (f32x4){0.f, 0.f, 0.f, 0.f};
    bf16x8 At[4][2], B0[2][2], B1[2][2];
    const char* cA = (const char*)g.A + (size_t)cur.pm * 2 * hstepA; const char* cB = (const char*)g.Bt + (size_t)cur.pn * 2 * hstepB;
    PG8_STAGE(PG8_SB(0, 0), cB, voffB); PG8_STAGE(PG8_SB(0, 1), cB + hstepB, voffB); PG8_STAGE(PG8_SA(0, 0), cA, voffA); PG8_STAGE(PG8_SA(0, 1), cA + hstepA, voffA);
    if (wr == 1) PG8_BAR;
    PG8_WAIT_V(2); PG8_BAR;
    PG8_STAGE(PG8_SB(1, 0), cB + kstep, voffB); PG8_STAGE(PG8_SA(1, 0), cA + kstep, voffA); PG8_STAGE(PG8_SB(1, 1), cB + hstepB + kstep, voffB);
    PG8_WAIT_V(6); PG8_BAR;
    for (;;) {
        const bool has_next = S.next(ui + 1, nxt);
        const char* nA = has_next ? (const char*)g.A + (size_t)nxt.pm * 2 * hstepA : cA; const char* nB = has_next ? (const char*)g.Bt + (size_t)nxt.pn * 2 * hstepB : cB;
        for (int t = 0; t < nt; t += 2) {
            const bool last = (t == nt - 2);
            const char* a1 = cA + (size_t)(t + 1) * kstep;
            const char* a2 = last ? nA : cA + (size_t)(t + 2) * kstep; const char* b2 = last ? nB : cB + (size_t)(t + 2) * kstep;
            const char* a3 = a2 + kstep; const char* b3 = b2 + kstep;
            PG8_LDB(B0, 0, 0); PG8_LDB(B1, 0, 1); PG8_SCHED; PG8_LDA(At, 0, 0); PG8_STAGE(PG8_SA(1, 1), a1 + hstepA, voffA);
            PG8_WAIT_V(8); PG8_WAIT_L(0); PG8_BAR; PG8_MMA(0, 0, At, B0); PG8_MMA(0, 1, At, B1); PG8_BAR; PG8_SCHED;
            PG8_LDA(At, 0, 1); PG8_STAGE(PG8_SB(0, 0), b2, voffB); PG8_STAGE(PG8_SB(0, 1), b2 + hstepB, voffB); PG8_STAGE(PG8_SA(0, 0), a2, voffA);
            PG8_WAIT_V(8); PG8_WAIT_L(0); PG8_BAR; PG8_MMA(1, 0, At, B0); PG8_MMA(1, 1, At, B1); PG8_BAR; PG8_SCHED;
            PG8_LDB(B0, 1, 0); PG8_LDB(B1, 1, 1); PG8_SCHED; PG8_LDA(At, 1, 0); PG8_STAGE(PG8_SA(0, 1), a2 + hstepA, voffA);
            PG8_WAIT_V(8); PG8_WAIT_L(0); PG8_BAR; PG8_MMA(0, 0, At, B0); PG8_MMA(0, 1, At, B1); PG8_BAR; PG8_SCHED;
            PG8_LDA(At, 1, 1); PG8_STAGE(PG8_SB(1, 0), b3, voffB); PG8_STAGE(PG8_SB(1, 1), b3 + hstepB, voffB); PG8_STAGE(PG8_SA(1, 0), a3, voffA);
            PG8_WAIT_V(8); PG8_WAIT_L(0); PG8_BAR; PG8_MMA(1, 0, At, B0); PG8_MMA(1, 1, At, B1); PG8_BAR; PG8_SCHED;
        }
        if constexpr (ALIGN_EPI) { if (wr == 0) PG8_BAR; }
        E(acc, cur, wr, wc, fr, fq);
        if (!has_next) break;
#pragma unroll
        for (int a = 0; a < 2; ++a)
#pragma unroll
            for (int b = 0; b < 2; ++b)
#pragma unroll
                for (int m = 0; m < 4; ++m)
#pragma unroll
                    for (int n = 0; n < 2; ++n) acc[a][b][m][n] = (f32x4){0.f, 0.f, 0.f, 0.f};
        cur = nxt; cA = nA; cB = nB; ++ui;
        if constexpr (ALIGN_EPI) { if (wr == 1) PG8_BAR; }
    }
    PG8_WAIT_V(0);
    if constexpr (!ALIGN_EPI) { if (wr == 0) PG8_BAR; }
    PG8_BAR;
#undef PG8_SA
#undef PG8_SB
#undef PG8_STAGE
#undef PG8_LDA
#undef PG8_LDB
#undef PG8_MMA
#undef PG8_WAIT_V
#undef PG8_WAIT_L
#undef PG8_BAR
#undef PG8_SCHED
}
}
namespace epi {
using pg8::Unit;
__device__ __forceinline__ int tix_of_row(int row) { return row < MPR ? (row & (SEQ - 1)) : (row < MV ? SEQ + (row & (DS - 1)) : 0); }

struct EpiIn {
    bf16_t* H; const float* cos64; const float* sin64;
    __device__ __forceinline__ void operator()(const f32x4 (&acc)[2][2][4][2], const Unit& u, int wr, int wc, int fr, int fq) const {
        const int type = u.pn >> 1;
        if (type == 1 || type == 2) {
            const float sc = (type == 2) ? 0.08838834764831845f : 1.0f;
            const int i0 = 16 * wc + 4 * fq;
#pragma unroll
            for (int ai = 0; ai < 2; ++ai)
#pragma unroll
                for (int m = 0; m < 4; ++m) {
                    const int row = u.pm * 256 + ai * 128 + wr * 64 + m * 16 + fr; const int tix = tix_of_row(row);
                    const f32x4 c = *(const f32x4*)(cos64 + tix * 64 + i0), s = *(const f32x4*)(sin64 + tix * 64 + i0);
#pragma unroll
                    for (int bj = 0; bj < 2; ++bj) {
                        const f32x4 x1 = acc[ai][bj][m][0], x2 = acc[ai][bj][m][1];
                        const f32x4 y1 = (x1 * c - x2 * s) * sc, y2 = (x2 * c + x1 * s) * sc;
                        bf16_t* p = H + (size_t)row * EIN + u.pn * 256 + bj * 128 + i0;
                        u32x2 w1, w2; w1.x = pk2(y1[0], y1[1]); w1.y = pk2(y1[2], y1[3]); w2.x = pk2(y2[0], y2[1]); w2.y = pk2(y2[2], y2[3]);
                        *(u32x2*)p = w1; *(u32x2*)(p + 64) = w2;
                    }
                    asm volatile("" ::: "memory");
                }
        } else {
#pragma unroll
            for (int ai = 0; ai < 2; ++ai)
#pragma unroll
                for (int m = 0; m < 4; ++m) {
                    const int row = u.pm * 256 + ai * 128 + wr * 64 + m * 16 + fr;
#pragma unroll
                    for (int bj = 0; bj < 2; ++bj) {
                        const f32x4 v0 = acc[ai][bj][m][0], v1 = acc[ai][bj][m][1];
                        u32x4 w; w.x = pk2(v0[0], v0[1]); w.y = pk2(v0[2], v0[3]); w.z = pk2(v1[0], v1[1]); w.w = pk2(v1[2], v1[3]);
                        *(u32x4*)(H + (size_t)row * EIN + u.pn * 256 + bj * 128 + wc * 32 + 8 * fq) = w;
                    }
                }
        }
    }
};

struct EpiZ {
    float* Z; int ldz; const bf16_t* res; int ldr; float alpha;
    __device__ __forceinline__ void operator()(const f32x4 (&acc)[2][2][4][2], const Unit& u, int wr, int wc, int fr, int fq) const {
#pragma unroll
        for (int ai = 0; ai < 2; ++ai)
#pragma unroll
            for (int m = 0; m < 4; ++m) {
                const int row = u.pm * 256 + ai * 128 + wr * 64 + m * 16 + fr;
#pragma unroll
                for (int bj = 0; bj < 2; ++bj)
#pragma unroll
                    for (int n = 0; n < 2; ++n) {
                        const int col = u.pn * 256 + bj * 128 + wc * 32 + n * 16 + 4 * fq;
                        f32x4 v = acc[ai][bj][m][n];
                        if (res) { const u32x2 r = *(const u32x2*)(res + (size_t)row * ldr + col); v[0] += alpha * bf_lo(r.x); v[1] += alpha * bf_hi(r.x); v[2] += alpha * bf_lo(r.y); v[3] += alpha * bf_hi(r.y); }
                        *(f32x4*)(Z + (size_t)row * ldz + col) = v;
                    }
            }
    }
};

struct EpiUp {
    bf16_t* Ab; bf16_t* Bb; float* conv_p; float* conv_s;
    __device__ __forceinline__ void operator()(const f32x4 (&acc)[2][2][4][2], const Unit& u, int wr, int wc, int fr, int fq) const {
#pragma unroll
        for (int ai = 0; ai < 2; ++ai)
#pragma unroll
            for (int m = 0; m < 4; ++m) {
                const int row = u.pm * 256 + ai * 128 + wr * 64 + m * 16 + fr;
                const int f0 = u.pn * 128 + wc * 32 + 8 * fq;
                const f32x4 a0 = acc[ai][0][m][0], a1 = acc[ai][0][m][1], b0 = acc[ai][1][m][0], b1 = acc[ai][1][m][1];
                u32x4 wa, wb; wa.x = pk2(a0[0], a0[1]); wa.y = pk2(a0[2], a0[3]); wa.z = pk2(a1[0], a1[1]); wa.w = pk2(a1[2], a1[3]);
                wb.x = pk2(b0[0], b0[1]); wb.y = pk2(b0[2], b0[3]); wb.z = pk2(b1[0], b1[1]); wb.w = pk2(b1[2], b1[3]);
                *(u32x4*)(Ab + (size_t)row * FF + f0) = wa; *(u32x4*)(Bb + (size_t)row * FF + f0) = wb;
                float* o = nullptr;
                if (row < MPR) { const int t = row & (SEQ - 1); if (t >= SEQ - 2) o = conv_p + ((size_t)(row >> 11) * 2 + (t - (SEQ - 2))) * FF + f0; }
                else if (row < MV) { const int t = row & 3; if (t >= 2) o = conv_s + ((size_t)((row - MPR) >> 2) * 2 + (t - 2)) * FF + f0; }
                if (o) { *(f32x4*)o = a0; *(f32x4*)(o + 4) = a1; }
            }
    }
};

struct EpiUq {
    bf16_t* Q; const float* cos32; const float* sin32;
    __device__ __forceinline__ void operator()(const f32x4 (&acc)[2][2][4][2], const Unit& u, int wr, int wc, int fr, int fq) const {
        if (u.pn < 4) {
#pragma unroll
            for (int ai = 0; ai < 2; ++ai)
#pragma unroll
                for (int m = 0; m < 4; ++m) {
                    const int row = u.pm * 256 + ai * 128 + wr * 64 + m * 16 + fr;
#pragma unroll
                    for (int bj = 0; bj < 2; ++bj) {
                        const f32x4 v0 = acc[ai][bj][m][0] * QSCALE, v1 = acc[ai][bj][m][1] * QSCALE;
                        u32x4 w; w.x = pk2(v0[0], v0[1]); w.y = pk2(v0[2], v0[3]); w.z = pk2(v1[0], v1[1]); w.w = pk2(v1[2], v1[3]);
                        *(u32x4*)(Q + ((size_t)row * MH + (2 * u.pn + bj)) * QKD + wc * 32 + 8 * fq) = w;
                    }
                }
        } else {
            const int i0 = 16 * (wc & 1) + 4 * fq;
#pragma unroll
            for (int ai = 0; ai < 2; ++ai)
#pragma unroll
                for (int m = 0; m < 4; ++m) {
                    const int row = u.pm * 256 + ai * 128 + wr * 64 + m * 16 + fr; const int tix = tix_of_row(row);
                    const f32x4 c = *(const f32x4*)(cos32 + tix * 32 + i0), s = *(const f32x4*)(sin32 + tix * 32 + i0);
#pragma unroll
                    for (int bj = 0; bj < 2; ++bj) {
                        const int h = 4 * (u.pn - 4) + 2 * bj + (wc >> 1);
                        const f32x4 x1 = acc[ai][bj][m][0], x2 = acc[ai][bj][m][1];
                        const f32x4 y1 = (x1 * c - x2 * s) * QSCALE, y2 = (x2 * c + x1 * s) * QSCALE;
                        bf16_t* p = Q + ((size_t)row * MH + h) * QKD + NOPE + i0;
                        u32x2 w1, w2; w1.x = pk2(y1[0], y1[1]); w1.y = pk2(y1[2], y1[3]); w2.x = pk2(y2[0], y2[1]); w2.y = pk2(y2[2], y2[3]);
                        *(u32x2*)p = w1; *(u32x2*)(p + 32) = w2;
                    }
                    asm volatile("" ::: "memory");
                }
        }
    }
};

struct EpiUkv {
    bf16_t* KF; bf16_t* V;
    __device__ __forceinline__ void operator()(const f32x4 (&acc)[2][2][4][2], const Unit& u, int wr, int wc, int fr, int fq) const {
        const bool isk = u.pn < 4; bf16_t* base = isk ? KF : V; const int hp = isk ? QKD : VD; const int h0 = 2 * (isk ? u.pn : u.pn - 4);
        const int row0 = u.pm * 256 + wr * 64 + fr;
        bf16_t* p0 = base + ((size_t)row0 * MH + h0) * hp + wc * 32 + 8 * fq;
#pragma unroll
        for (int ai = 0; ai < 2; ++ai)
#pragma unroll
            for (int m = 0; m < 4; ++m) {
#pragma unroll
                for (int bj = 0; bj < 2; ++bj) {
                    const f32x4 v0 = acc[ai][bj][m][0], v1 = acc[ai][bj][m][1];
                    u32x4 w; w.x = pk2(v0[0], v0[1]); w.y = pk2(v0[2], v0[3]); w.z = pk2(v1[0], v1[1]); w.w = pk2(v1[2], v1[3]);
                    *(u32x4*)(p0 + ((size_t)(ai * 128 + m * 16) * MH + bj) * hp) = w;
                }
            }
    }
};
}
constexpr size_t MiB = 1u << 20;
constexpr size_t al(size_t x) { return (x + 255) & ~(size_t)255; }
constexpr size_t WS_CTL = 0;
constexpr size_t WS_WIN = 1 * MiB;
constexpr size_t WS_WCAT = WS_WIN + (size_t)EIN * DM * 2;
constexpr size_t WS_WUP0 = WS_WCAT + (size_t)DM * DM * 2;
constexpr size_t WS_WUP1 = WS_WUP0 + (size_t)2 * FF * DM * 2;
constexpr size_t WS_WDN0 = WS_WUP1 + (size_t)2 * FF * DM * 2;
constexpr size_t WS_WDN1 = WS_WDN0 + (size_t)DM * FF * 2;
constexpr size_t WS_WDQKV = WS_WDN1 + (size_t)DM * FF * 2;
constexpr size_t WS_WUQ = WS_WDQKV + (size_t)DM * DM * 2;
constexpr size_t WS_WUKV = WS_WUQ + (size_t)1536 * QL * 2;
constexpr size_t WS_WOM = WS_WUKV + (size_t)2048 * KVL * 2;
constexpr size_t WS_TAB = WS_WOM + (size_t)DM * DM * 2;
constexpr size_t TAB64 = (size_t)NPOS * 64 * 4, TAB32 = (size_t)NPOS * 32 * 4;
constexpr size_t WS_X0 = al(WS_TAB + 2 * TAB64 + 2 * TAB32);
constexpr size_t WS_X1 = WS_X0 + (size_t)MP * DM * 2;
constexpr size_t WS_CAT = WS_X1 + (size_t)MP * DM * 2;
constexpr size_t WS_Z = WS_CAT + (size_t)MP * DM * 2;
constexpr size_t WS_H = WS_Z + (size_t)MP * DM * 4;
constexpr size_t WS_AB = WS_H + (size_t)MP * EIN * 2;
constexpr size_t WS_BB = WS_AB + (size_t)MP * FF * 2;
constexpr size_t WS_G = WS_BB + (size_t)MP * FF * 2;
constexpr size_t WS_KVLOC = WS_G + (size_t)MP * FF * 2;
constexpr size_t WS_STB = WS_KVLOC + (size_t)512 * 128 * 128 * 4;
constexpr size_t WS_CQN = WS_STB + (size_t)512 * 128 * 128 * 2;
constexpr size_t WS_CKVN = WS_CQN + (size_t)MP * QL * 2;
constexpr size_t WS_KPEB = WS_CKVN + (size_t)MP * KVL * 2;
constexpr size_t WS_Q = al(WS_KPEB + (size_t)MS * ROPE * 2);
constexpr size_t WS_KF = WS_Q + (size_t)MP * MH * QKD * 2;
constexpr size_t WS_V = WS_KF + (size_t)MP * MH * QKD * 2;
constexpr size_t WS_PART = WS_V + (size_t)MP * MH * VD * 2;
constexpr size_t WS_QLAT = WS_PART + (size_t)DB * 8 * 32 * 264 * 4;
constexpr size_t WS_END = WS_QLAT + (size_t)DB * 32 * 320 * 4;

constexpr size_t O_YP = 0;
constexpr size_t O_YS = O_YP + (size_t)MPR * DM;
constexpr size_t O_POOLP = O_YS + (size_t)MS * DM;
constexpr size_t O_POOLS = O_POOLP + (size_t)NB * HIST * POOLD;
constexpr size_t O_RETP = O_POOLS + (size_t)DB * HIST * POOLD;
constexpr size_t O_RETS = O_RETP + (size_t)NB * RH * RD * RD;
constexpr size_t O_CKVP = O_RETS + (size_t)DB * RH * RD * RD;
constexpr size_t O_CKVS = O_CKVP + (size_t)MPR * KVL;
constexpr size_t O_KPEP = O_CKVS + (size_t)MS * KVL;
constexpr size_t O_KPES = O_KPEP + (size_t)MPR * ROPE;
constexpr size_t O_CONVP = O_KPES + (size_t)MS * ROPE;
constexpr size_t O_CONVS = O_CONVP + (size_t)2 * NB * 2 * FF;
constexpr size_t O_END = O_CONVS + (size_t)2 * DB * 2 * FF;

#define ARG_LIST(X) \
    X(const float*, x_prompt) X(const float*, x_sample) X(const float*, state_pool) X(const float*, state_ret) X(const float*, cache_ckv) X(const float*, cache_kpe) X(const float*, state_conv) X(const int*, page_table) \
    X(const float*, w_in) X(const float*, pool_w) X(const float*, pool_scale) X(const float*, gn_g) X(const float*, w_o_even) X(const float*, w_dq) X(const float*, q_norm_g) X(const float*, w_uq) X(const float*, w_dkv) \
    X(const float*, kv_norm_g) X(const float*, w_uk) X(const float*, w_uv) X(const float*, w_o_mla) X(const float*, w_up) X(const float*, conv_w) X(const float*, conv_b) X(const float*, w_down) \
    X(const float*, ln_mix_g) X(const float*, ln_mix_b) X(const float*, ln_ffn_g) X(const float*, ln_ffn_b) X(float*, out) X(unsigned char*, ws)
struct Args {
#define X(T, n) T n;
    ARG_LIST(X)
#undef X
    int ph_lo, ph_hi; int dbg, pad;
};
enum ArgIdx {
#define X(T, n) AI_##n,
    ARG_LIST(X)
#undef X
    AI_COUNT
};
template <class T> __device__ __forceinline__ T ldarg(const LAS unsigned* sa, int idx) {
    const unsigned lo = __builtin_amdgcn_readfirstlane(sa[2 * idx]), hi = __builtin_amdgcn_readfirstlane(sa[2 * idx + 1]);
    return (T)(((unsigned long long)hi << 32) | lo);
}

__device__ __forceinline__ int map_a(int p) { return (p & 96) + 8 * ((p >> 2) & 3) + 4 * ((p >> 4) & 1) + (p & 3); }
__device__ __forceinline__ int map_r64(int p) { return 64 * ((p >> 4) & 1) + 16 * (p >> 5) + 4 * ((p >> 2) & 3) + (p & 3); }

struct FIn { const float* w; __device__ __forceinline__ float operator()(int k, int P) const { const int pn = P >> 8, ty = pn >> 1, p = P & 127; const int L = (P & ~127) + ((ty == 1 || ty == 2) ? map_r64(p) : map_a(p)); return w[(size_t)k * EIN + L]; } };
struct FCat { const float *wo, *pw, *ps; __device__ __forceinline__ float operator()(int k, int P) const {
    if (k >= POOLD) return wo[(size_t)k * DM + P];
    const int g = k >> 7, c = k & 127; const float* pwr = pw + ((size_t)g * 128 + c) * 128; const float* psr = ps + g * 128; const float* wor = wo + (size_t)(g * 128) * DM + P;
    float s = 0.f;
#pragma unroll 8
    for (int d = 0; d < 128; ++d) s += pwr[d] * psr[d] * wor[(size_t)d * DM];
    return s; } };
struct FUp { const float* w; __device__ __forceinline__ float operator()(int k, int P) const { const int pn = P >> 8, bj = (P >> 7) & 1; return w[(size_t)k * (2 * FF) + (bj ? FF : 0) + pn * 128 + map_a(P & 127)]; } };
struct FNat { const float* w; int ldw; __device__ __forceinline__ float operator()(int k, int P) const { return w[(size_t)k * ldw + P]; } };
struct FDqkv { const float *wdq, *wdkv; __device__ __forceinline__ float operator()(int k, int P) const { return P < QL ? wdq[(size_t)k * QL + P] : (P < QL + KVL + ROPE ? wdkv[(size_t)k * (KVL + ROPE) + (P - QL)] : 0.f); } };
struct FUq { const float* w; __device__ __forceinline__ float operator()(int k, int P) const {
    int src;
    if (P < 1024) { src = (P >> 7) * QKD + map_a(P & 127); }
    else { const int Pp = P - 1024, pn = Pp >> 8, bj = (Pp >> 7) & 1, p = Pp & 127, wc = p >> 5, n = (p >> 4) & 1, fq = (p >> 2) & 3, j = p & 3;
        src = (4 * pn + 2 * bj + (wc >> 1)) * QKD + NOPE + 32 * n + 16 * (wc & 1) + 4 * fq + j; }
    return w[(size_t)k * (MH * QKD) + src]; } };
struct FUkv { const float *wuk, *wuv; __device__ __forceinline__ float operator()(int k, int P) const { const int Pp = P & 1023; const float* w = P < 1024 ? wuk : wuv; return w[(size_t)k * 1024 + (Pp >> 7) * 128 + map_a(Pp & 127)]; } };

template <class F>
__device__ __forceinline__ void tr_item(const F& f, int K, bf16_t* WT, LAS float* scr, int item, int nblk, int lane) {
    const int kb = item / nblk, nb = item % nblk, k0 = 64 * kb, n0 = 32 * nb;
#pragma unroll 4
    for (int i = 0; i < 32; ++i) { const int kk = 2 * i + (lane >> 5); scr[kk * 33 + (lane & 31)] = f(k0 + kk, n0 + (lane & 31)); }
    asm volatile("s_waitcnt lgkmcnt(0)" ::: "memory");
    const int c = lane & 7;
#pragma unroll
    for (int j = 0; j < 4; ++j) { const int n = (lane >> 3) + 8 * j; const LAS float* s = scr + (8 * c) * 33 + n;
        u32x4 o; o.x = pk2(s[0 * 33], s[1 * 33]); o.y = pk2(s[2 * 33], s[3 * 33]); o.z = pk2(s[4 * 33], s[5 * 33]); o.w = pk2(s[6 * 33], s[7 * 33]);
        *(u32x4*)(WT + (size_t)(n0 + n) * K + k0 + 8 * c) = o; }
    asm volatile("s_waitcnt lgkmcnt(0)" ::: "memory");
}

__device__ __forceinline__ void sincos_d(double ang, float& c, float& s) {
    const double TWO_PI = 6.283185307179586476925286766559;
    const double n = __builtin_rint(ang / TWO_PI); const double r = ang - n * TWO_PI; const double r2 = r * r;
    double tc = 1.0, ts = r, sc = 1.0, ss = r;
#pragma unroll 1
    for (int k = 1; k <= 14; ++k) { tc *= -r2 / (double)((2 * k - 1) * (2 * k)); ts *= -r2 / (double)((2 * k) * (2 * k + 1)); sc += tc; ss += ts; }
    c = (float)sc; s = (float)ss;
}

__device__ __forceinline__ void p0_prologue(const Args& a, LAS unsigned char* lds, int gw, int NGW, int lane, int gtid, int gsz) {
    unsigned char* ws = a.ws;
    LAS float* scr = (LAS float*)(lds + (threadIdx.x >> 6) * 8704);
    constexpr int I_IN = 16 * 80, I_CAT = 16 * 32, I_UP = 16 * 176, I_DN = 44 * 32, I_DQKV = 16 * 32, I_UQ = 8 * 48, I_UKV = 4 * 64, I_OM = 16 * 32;
    constexpr int NIT = I_IN + I_CAT + 2 * I_UP + 2 * I_DN + I_DQKV + I_UQ + I_UKV + I_OM;
    for (int it = gw; it < NIT; it += NGW) {
        int r = it;
        if (r < I_CAT) { tr_item(FCat{a.w_o_even, a.pool_w, a.pool_scale}, DM, (bf16_t*)(ws + WS_WCAT), scr, r, 32, lane); continue; } r -= I_CAT;
        if (r < I_IN) { tr_item(FIn{a.w_in}, DM, (bf16_t*)(ws + WS_WIN), scr, r, 80, lane); continue; } r -= I_IN;
        if (r < I_UP) { tr_item(FUp{a.w_up}, DM, (bf16_t*)(ws + WS_WUP0), scr, r, 176, lane); continue; } r -= I_UP;
        if (r < I_UP) { tr_item(FUp{a.w_up + (size_t)DM * 2 * FF}, DM, (bf16_t*)(ws + WS_WUP1), scr, r, 176, lane); continue; } r -= I_UP;
        if (r < I_DN) { tr_item(FNat{a.w_down, DM}, FF, (bf16_t*)(ws + WS_WDN0), scr, r, 32, lane); continue; } r -= I_DN;
        if (r < I_DN) { tr_item(FNat{a.w_down + (size_t)FF * DM, DM}, FF, (bf16_t*)(ws + WS_WDN1), scr, r, 32, lane); continue; } r -= I_DN;
        if (r < I_DQKV) { tr_item(FDqkv{a.w_dq, a.w_dkv}, DM, (bf16_t*)(ws + WS_WDQKV), scr, r, 32, lane); continue; } r -= I_DQKV;
        if (r < I_UQ) { tr_item(FUq{a.w_uq}, QL, (bf16_t*)(ws + WS_WUQ), scr, r, 48, lane); continue; } r -= I_UQ;
        if (r < I_UKV) { tr_item(FUkv{a.w_uk, a.w_uv}, KVL, (bf16_t*)(ws + WS_WUKV), scr, r, 64, lane); continue; } r -= I_UKV;
        tr_item(FNat{a.w_o_mla, DM}, DM, (bf16_t*)(ws + WS_WOM), scr, r, 32, lane);
    }
    bf16_t* X0 = (bf16_t*)(ws + WS_X0);
    for (int row = gw; row < MP; row += NGW) {
        const float* src = row < MPR ? a.x_prompt + (size_t)row * DM : (row < MV ? a.x_sample + (size_t)(row - MPR) * DM : nullptr);
#pragma unroll
        for (int j = 0; j < 4; ++j) { f32x4 v = src ? *(const f32x4*)(src + 256 * j + 4 * lane) : (f32x4){0.f, 0.f, 0.f, 0.f};
            u32x2 w; w.x = pk2(v[0], v[1]); w.y = pk2(v[2], v[3]); *(u32x2*)(X0 + (size_t)row * DM + 256 * j + 4 * lane) = w; }
    }
    float* c64 = (float*)(ws + WS_TAB); float* s64 = c64 + NPOS * 64; float* c32 = s64 + NPOS * 64; float* s32 = c32 + NPOS * 32;
    for (int e = gtid; e < NPOS * 96; e += gsz) {
        const int tix = e / 96, i = e % 96; const double pos = tix < SEQ ? (double)tix : (double)(PAST + tix - SEQ);
        const bool is64 = i < 64; const int ii = is64 ? i : i - 64; const double rr = is64 ? 0.8659643233600653523531691834 : 0.7498942093324558273021842756;
        double inv = 1.0; for (int q = 0; q < ii; ++q) inv *= rr;
        float c, s; sincos_d(pos * inv, c, s);
        if (is64) { c64[tix * 64 + ii] = c; s64[tix * 64 + ii] = s; } else { c32[tix * 32 + ii] = c; s32[tix * 32 + ii] = s; }
    }
}

__device__ __forceinline__ void ln_pass(const float* Z, const float* g, const float* b, bf16_t* X, float* outp, float* outs, int gw, int NGW, int lane) {
    for (int row = gw; row < MV; row += NGW) {
        const float* z = Z + (size_t)row * DM; f32x4 v[4]; float s = 0.f;
#pragma unroll
        for (int j = 0; j < 4; ++j) { v[j] = *(const f32x4*)(z + 256 * j + 4 * lane); s += (v[j][0] + v[j][1]) + (v[j][2] + v[j][3]); }
        const float mean = wave_sum(s) * (1.f / DM); float q = 0.f;
#pragma unroll
        for (int j = 0; j < 4; ++j) { v[j] = v[j] - mean; q += (v[j][0] * v[j][0] + v[j][1] * v[j][1]) + (v[j][2] * v[j][2] + v[j][3] * v[j][3]); }
        const float rstd = 1.0f / sqrtf(wave_sum(q) * (1.f / DM) + LN_EPS);
        float* o = outp ? (row < MPR ? outp + (size_t)row * DM : outs + (size_t)(row - MPR) * DM) : nullptr;
#pragma unroll
        for (int j = 0; j < 4; ++j) { const f32x4 gg = *(const f32x4*)(g + 256 * j + 4 * lane), bb = *(const f32x4*)(b + 256 * j + 4 * lane);
            const f32x4 y = v[j] * rstd * gg + bb;
            if (X) { u32x2 w; w.x = pk2(y[0], y[1]); w.y = pk2(y[2], y[3]); *(u32x2*)(X + (size_t)row * DM + 256 * j + 4 * lane) = w; }
            if (o) *(f32x4*)(o + 256 * j + 4 * lane) = y; }
    }
}

__device__ __forceinline__ void load8(const bf16_t* p, float (&v)[8]) { const u32x4 w = *(const u32x4*)p; v[0] = bf_lo(w.x); v[1] = bf_hi(w.x); v[2] = bf_lo(w.y); v[3] = bf_hi(w.y); v[4] = bf_lo(w.z); v[5] = bf_hi(w.z); v[6] = bf_lo(w.w); v[7] = bf_hi(w.w); }
__device__ __forceinline__ void load8f(const float* p, float (&v)[8]) { const f32x4 a = *(const f32x4*)p, b = *(const f32x4*)(p + 4); v[0] = a[0]; v[1] = a[1]; v[2] = a[2]; v[3] = a[3]; v[4] = b[0]; v[5] = b[1]; v[6] = b[2]; v[7] = b[3]; }
__device__ __forceinline__ void store8(bf16_t* p, const float (&v)[8]) { u32x4 w; w.x = pk2(v[0], v[1]); w.y = pk2(v[2], v[3]); w.z = pk2(v[4], v[5]); w.w = pk2(v[6], v[7]); *(u32x4*)p = w; }

__device__ __forceinline__ void conv_gate_pass(const bf16_t* Ab, const bf16_t* Bb, bf16_t* G, const float* cw, const float* cb, const float* sconv  , int gtid, int gsz) {
    constexpr int CH = FF / 8;
    for (int it = gtid; it < MV * CH; it += gsz) {
        const int row = it / CH, f0 = (it % CH) * 8;
        float a0[8], a1[8], a2[8], bb[8], w0[8], w1[8], w2[8], c0[8], o[8];
        load8(Ab + (size_t)row * FF + f0, a0); load8(Bb + (size_t)row * FF + f0, bb);
        load8f(cw + f0, w0); load8f(cw + FF + f0, w1); load8f(cw + 2 * FF + f0, w2); load8f(cb + f0, c0);
        int t; const float* h1 = nullptr; const float* h2 = nullptr;
        if (row < MPR) t = row & (SEQ - 1); else { t = row & 3; const int b = (row - MPR) >> 2; const float* hb = sconv + (size_t)b * 2 * FF + f0; if (t == 0) { h1 = hb + FF; h2 = hb; } else if (t == 1) { h2 = hb + FF; } }
        if (t >= 1) load8(Ab + (size_t)(row - 1) * FF + f0, a1); else if (h1) load8f(h1, a1); else { for (int j = 0; j < 8; ++j) a1[j] = 0.f; }
        if (t >= 2) load8(Ab + (size_t)(row - 2) * FF + f0, a2); else if (h2) load8f(h2, a2); else { for (int j = 0; j < 8; ++j) a2[j] = 0.f; }
#pragma unroll
        for (int j = 0; j < 8; ++j) { const float cv = c0[j] + w0[j] * a2[j] + w1[j] * a1[j] + w2[j] * a0[j]; o[j] = silu_f(cv) * bb[j]; }
        store8(G + (size_t)row * FF + f0, o);
    }
}
typedef short v4i16_t __attribute__((ext_vector_type(4)));
__device__ __forceinline__ s16x4 tr4(const LAS unsigned char* p) { return __builtin_bit_cast(s16x4, __builtin_amdgcn_ds_read_tr16_b64_v4i16((LAS v4i16_t*)p)); }
__device__ __forceinline__ bf16x8 frag_tr(const LAS unsigned char* tile, int pitch, int k0, int n0, int lane) {
    const int h = lane >> 5, blk = (lane >> 4) & 1, q = (lane & 15) >> 2, p = lane & 3;
    const LAS unsigned char* base = tile + (k0 + 8 * h + q) * pitch + (n0 + 16 * blk + 4 * p) * 2;
    const s16x4 lo = tr4(base), hi = tr4(base + 4 * pitch);
    return (bf16x8){lo[0], lo[1], lo[2], lo[3], hi[0], hi[1], hi[2], hi[3]};
}
__device__ __forceinline__ bf16x8 frag_tr_acc(const LAS unsigned char* tile, int pitch, int k0, int n0, int lane) {
    const int h = lane >> 5, blk = (lane >> 4) & 1, q = (lane & 15) >> 2, p = lane & 3;
    const LAS unsigned char* base = tile + (k0 + 4 * h + q) * pitch + (n0 + 16 * blk + 4 * p) * 2;
    const s16x4 lo = tr4(base), hi = tr4(base + 8 * pitch);
    return (bf16x8){lo[0], lo[1], lo[2], lo[3], hi[0], hi[1], hi[2], hi[3]};
}
__device__ __forceinline__ bf16x8 frag_row(const LAS unsigned char* tile, int pitch, int r0, int k0, int lane) {
    return *(const LAS bf16x8*)(tile + (r0 + (lane & 31)) * pitch + (k0 + 8 * (lane >> 5)) * 2);
}
__device__ __forceinline__ int crow(int r, int hi) { return (r & 3) + 8 * (r >> 2) + 4 * hi; }
__device__ __forceinline__ bf16x8 acc_frag(const f32x16& x, int s) {
    u32x4 w; w.x = pk2(x[8 * s + 0], x[8 * s + 1]); w.y = pk2(x[8 * s + 2], x[8 * s + 3]); w.z = pk2(x[8 * s + 4], x[8 * s + 5]); w.w = pk2(x[8 * s + 6], x[8 * s + 7]);
    return __builtin_bit_cast(bf16x8, w);
}
#define MFMA32(a, b, c) __builtin_amdgcn_mfma_f32_32x32x16_bf16((a), (b), (c), 0, 0, 0)

__device__ __forceinline__ float log2gamma(int h) { return h == 0 ? -0.04580368961312479f : (h == 1 ? -0.02272007650008353f : (h == 2 ? -0.011315313227834147f : -0.005646563141142062f)); }

constexpr int TP = 288;

__device__ __forceinline__ void pool_pass(const float* state_pool, float* outp, const bf16_t* H, bf16_t* CAT, int gtid, int gsz) {
    for (int it = gtid; it < MV * 64; it += gsz) {
        const int row = it >> 6, ch0 = (it & 63) * 8, w = 2 << (ch0 >> 7);
        float u0[8], s[8], t8[8];
        load8(H + (size_t)row * EIN + ch0, u0);
#pragma unroll
        for (int j = 0; j < 8; ++j) s[j] = u0[j];
        float cnt;
        if (row < MPR) { const int t = row & (SEQ - 1); const int n = (w < t + 1) ? w : t + 1; cnt = (float)n;
            for (int q = 1; q < n; ++q) { load8(H + (size_t)(row - q) * EIN + ch0, t8);
#pragma unroll
                for (int j = 0; j < 8; ++j) s[j] += t8[j]; } }
        else { const int t = row & 3, b = (row - MPR) >> 2; cnt = (float)w;
            for (int q = 1; q < w; ++q) { const int e = HIST + t - q;
                if (e >= HIST) load8(H + (size_t)(row - q) * EIN + ch0, t8); else load8f(state_pool + ((size_t)b * HIST + e) * POOLD + ch0, t8);
#pragma unroll
                for (int j = 0; j < 8; ++j) s[j] += t8[j]; } }
        const float ic = 1.0f / cnt;
#pragma unroll
        for (int j = 0; j < 8; ++j) s[j] = s[j] * ic - u0[j];
        store8(CAT + (size_t)row * DM + ch0, s);
    }
    for (int it = gtid; it < (NB + DB) * HIST * 64; it += gsz) {
        const int ch0 = (it & 63) * 8, ri = it >> 6; float v[8];
        if (ri < NB * HIST) { const int b = ri / HIST, i = ri % HIST; load8(H + (size_t)(b * SEQ + SEQ - HIST + i) * EIN + ch0, v);
            float* o = outp + O_POOLP + (size_t)ri * POOLD + ch0; *(f32x4*)o = (f32x4){v[0], v[1], v[2], v[3]}; *(f32x4*)(o + 4) = (f32x4){v[4], v[5], v[6], v[7]}; }
        else { const int r2 = ri - NB * HIST, b = r2 / HIST, i = r2 % HIST;
            if (i < HIST - DS) load8f(state_pool + ((size_t)b * HIST + DS + i) * POOLD + ch0, v); else load8(H + (size_t)(MPR + b * DS + i - (HIST - DS)) * EIN + ch0, v);
            float* o = outp + O_POOLS + (size_t)r2 * POOLD + ch0; *(f32x4*)o = (f32x4){v[0], v[1], v[2], v[3]}; *(f32x4*)(o + 4) = (f32x4){v[4], v[5], v[6], v[7]}; }
    }
}

__device__ __forceinline__ void ret_r1_unit(int unit, const bf16_t* H, float* KVLOC, LAS unsigned char* lds) {
    const int tid = threadIdx.x, lane = tid & 63, wid = tid >> 6, hh = unit & 3, bc = unit >> 2; const int row0 = bc * 128;
    const float l2g = log2gamma(hh);
    LAS unsigned char* Kt = lds; LAS unsigned char* Vt = lds + 128 * TP;
#pragma unroll
    for (int i = 0; i < 4; ++i) { const int ch = tid + 512 * i, r = ch >> 4, cc = ch & 15;
        const bf16_t* src = H + (size_t)(row0 + r) * EIN + hh * 128 + cc * 8;
        const u32x4 vv = *(const u32x4*)(src + 1536); float kk[8]; load8(src + 1024, kk);
        const float kd = __builtin_amdgcn_exp2f((float)(127 - r) * l2g);
#pragma unroll
        for (int j = 0; j < 8; ++j) kk[j] *= kd;
        u32x4 kw; kw.x = pk2(kk[0], kk[1]); kw.y = pk2(kk[2], kk[3]); kw.z = pk2(kk[4], kk[5]); kw.w = pk2(kk[6], kk[7]);
        *(LAS u32x4*)(Kt + r * TP + cc * 16) = kw; *(LAS u32x4*)(Vt + r * TP + cc * 16) = vv; }
    __syncthreads();
    const int vb = wid >> 1, db0 = 2 * (wid & 1);
    f32x16 acc0 = {}, acc1 = {};
#pragma unroll
    for (int ks = 0; ks < 8; ++ks) {
        const bf16x8 af = frag_tr(Vt, TP, 16 * ks, 32 * vb, lane);
        const bf16x8 b0 = frag_tr(Kt, TP, 16 * ks, 32 * db0, lane), b1 = frag_tr(Kt, TP, 16 * ks, 32 * (db0 + 1), lane);
        acc0 = MFMA32(af, b0, acc0); acc1 = MFMA32(af, b1, acc1);
    }
    float* o = KVLOC + (size_t)unit * 16384; const int hi = lane >> 5, c32 = lane & 31;
#pragma unroll
    for (int r = 0; r < 16; ++r) { const int v = 32 * vb + crow(r, hi); o[v * 128 + 32 * db0 + c32] = acc0[r]; o[v * 128 + 32 * (db0 + 1) + c32] = acc1[r]; }
    __syncthreads();
}

__device__ __forceinline__ void ret_scan_pass(const float* KVLOC, bf16_t* STB, float* out_retp, int gtid, int gsz) {
    for (int e = gtid; e < NB * RH * 16384; e += gsz) {
        const int vd = e & 16383, hh = (e >> 14) & 3, b = e >> 16; const float g128 = __builtin_amdgcn_exp2f(128.0f * log2gamma(hh));
        float s = 0.f;
#pragma unroll 4
        for (int c = 0; c < 16; ++c) { const size_t idx = ((size_t)((b * 16 + c) * 4 + hh)) * 16384 + vd; STB[idx] = f2bf(s); s = g128 * s + KVLOC[idx]; }
        const int v = vd >> 7, d = vd & 127;
        out_retp[((size_t)(b * RH + hh) * RD + d) * RD + v] = s;
    }
}

__device__ __forceinline__ void ret_r3_unit(int unit, const float* gn_g, const bf16_t* H, const bf16_t* STB, bf16_t* CAT, LAS unsigned char* lds) {
    const int tid = threadIdx.x, lane = tid & 63, wid = tid >> 6, hh = unit & 3, bc = unit >> 2; const int row0 = bc * 128;
    const int hi = lane >> 5, c32 = lane & 31; const float l2g = log2gamma(hh);
    LAS unsigned char* Kt = lds; LAS unsigned char* Vt = lds + 128 * TP; LAS float* red = (LAS float*)(lds + 256 * TP);
#pragma unroll
    for (int i = 0; i < 4; ++i) { const int ch = tid + 512 * i, r = ch >> 4, cc = ch & 15;
        const bf16_t* src = H + (size_t)(row0 + r) * EIN + hh * 128 + cc * 8;
        *(LAS u32x4*)(Kt + r * TP + cc * 16) = *(const u32x4*)(src + 1024); *(LAS u32x4*)(Vt + r * TP + cc * 16) = *(const u32x4*)(src + 1536); }
    const int lb = wid & 3, vh = wid >> 2; const int lq = 32 * lb + c32;
    bf16x8 qf[8];
#pragma unroll
    for (int s = 0; s < 8; ++s) qf[s] = *(const bf16x8*)(H + (size_t)(row0 + lq) * EIN + 512 + hh * 128 + 16 * s + 8 * hi);
    __syncthreads();
    f32x16 o0 = {}, o1 = {};
    for (int mb = 0; mb <= lb; ++mb) {
        f32x16 x = {};
#pragma unroll
        for (int s = 0; s < 8; ++s) x = MFMA32(frag_row(Kt, TP, 32 * mb, 16 * s, lane), qf[s], x);
#pragma unroll
        for (int r = 0; r < 16; ++r) { const int dl = lq - (32 * mb + crow(r, hi)); x[r] = dl >= 0 ? x[r] * __builtin_amdgcn_exp2f((float)dl * l2g) : 0.f; }
#pragma unroll
        for (int s2 = 0; s2 < 2; ++s2) { const bf16x8 pf = acc_frag(x, s2);
            o0 = MFMA32(frag_tr_acc(Vt, TP, 32 * mb + 16 * s2, 32 * (2 * vh), lane), pf, o0);
            o1 = MFMA32(frag_tr_acc(Vt, TP, 32 * mb + 16 * s2, 32 * (2 * vh + 1), lane), pf, o1); }
    }
    f32x16 i0 = {}, i1 = {};
    const bf16_t* st = STB + (size_t)unit * 16384;
#pragma unroll
    for (int s = 0; s < 8; ++s) {
        const bf16x8 a0 = *(const bf16x8*)(st + (size_t)(32 * (2 * vh) + c32) * 128 + 16 * s + 8 * hi), a1 = *(const bf16x8*)(st + (size_t)(32 * (2 * vh + 1) + c32) * 128 + 16 * s + 8 * hi);
        i0 = MFMA32(a0, qf[s], i0); i1 = MFMA32(a1, qf[s], i1);
    }
    const float qdec = __builtin_amdgcn_exp2f((float)(lq + 1) * l2g);
    float s1 = 0.f, s2 = 0.f;
#pragma unroll
    for (int r = 0; r < 16; ++r) { o0[r] += qdec * i0[r]; o1[r] += qdec * i1[r]; s1 += o0[r] + o1[r]; s2 += o0[r] * o0[r] + o1[r] * o1[r]; }
    s1 += __shfl_xor(s1, 32); s2 += __shfl_xor(s2, 32);
    if (hi == 0) { red[(wid * 32 + c32) * 2] = s1; red[(wid * 32 + c32) * 2 + 1] = s2; }
    __syncthreads();
    { const int pw = wid ^ 4; s1 += red[(pw * 32 + c32) * 2]; s2 += red[(pw * 32 + c32) * 2 + 1]; }
    const float mean = s1 * (1.f / 128.f), var = s2 * (1.f / 128.f) - mean * mean, rstd = 1.0f / sqrtf(var + GN_EPS);
    const int row = row0 + lq;
#pragma unroll
    for (int vbi = 0; vbi < 2; ++vbi)
#pragma unroll
        for (int rg = 0; rg < 4; ++rg) {
            const int v0 = 32 * (2 * vh + vbi) + 8 * rg + 4 * hi;
            const f32x4 gn = *(const f32x4*)(gn_g + hh * 128 + v0); const u32x2 gw = *(const u32x2*)(H + (size_t)row * EIN + 2048 + hh * 128 + v0);
            const float gt[4] = {bf_lo(gw.x), bf_hi(gw.x), bf_lo(gw.y), bf_hi(gw.y)}; float y[4];
#pragma unroll
            for (int j = 0; j < 4; ++j) { const float ov = vbi ? o1[4 * rg + j] : o0[4 * rg + j]; y[j] = silu_f(gt[j]) * ((ov - mean) * rstd * gn[j]); }
            u32x2 w; w.x = pk2(y[0], y[1]); w.y = pk2(y[2], y[3]); *(u32x2*)(CAT + (size_t)row * DM + POOLD + hh * 128 + v0) = w;
        }
    __syncthreads();
}

__device__ __forceinline__ void ret_sample_unit(int unit, const float* state_ret, float* outp, const float* gn_g, const bf16_t* H, bf16_t* CAT, LAS unsigned char* lds) {
    const int tid = threadIdx.x, b = unit >> 2, hh = unit & 3; const float l2g = log2gamma(hh);
    LAS float* qs = (LAS float*)lds; LAS float* ks = qs + 512; LAS float* vs = ks + 512; LAS float* A = vs + 512; LAS float* red = A + 16; LAS float* st = red + 2048;
    { const int l = tid >> 7, d = tid & 127; const bf16_t* hr = H + (size_t)(MPR + b * DS + l) * EIN + hh * 128 + d;
        qs[tid] = bf2f(hr[512]); ks[tid] = bf2f(hr[1024]); vs[tid] = bf2f(hr[1536]); }
    __syncthreads();
    if (tid < 16) { const int l = tid >> 2, m = tid & 3; float s = 0.f; for (int d = 0; d < 128; ++d) s += qs[l * 128 + d] * ks[m * 128 + d]; A[tid] = (m <= l) ? s * __builtin_amdgcn_exp2f((float)(l - m) * l2g) : 0.f; }
    const int v = tid & 127, dg = tid >> 7;
    const float g4 = __builtin_amdgcn_exp2f(4.f * l2g), kd0 = __builtin_amdgcn_exp2f(3.f * l2g), kd1 = __builtin_amdgcn_exp2f(2.f * l2g), kd2 = __builtin_amdgcn_exp2f(l2g);
    const float v0 = vs[v] * kd0, v1 = vs[128 + v] * kd1, v2 = vs[256 + v] * kd2, v3 = vs[384 + v];
    const float* S = state_ret + ((size_t)(b * RH + hh) * RD) * RD; float* So = outp + O_RETS + ((size_t)(b * RH + hh) * RD) * RD;
    float p0 = 0.f, p1 = 0.f, p2 = 0.f, p3 = 0.f;
#pragma unroll 4
    for (int i = 0; i < 32; ++i) { const int d = dg * 32 + i; const float sv = S[d * 128 + v];
        So[d * 128 + v] = g4 * sv + ks[d] * v0 + ks[128 + d] * v1 + ks[256 + d] * v2 + ks[384 + d] * v3;
        p0 += qs[d] * sv; p1 += qs[128 + d] * sv; p2 += qs[256 + d] * sv; p3 += qs[384 + d] * sv; }
    red[(dg * 4 + 0) * 128 + v] = p0; red[(dg * 4 + 1) * 128 + v] = p1; red[(dg * 4 + 2) * 128 + v] = p2; red[(dg * 4 + 3) * 128 + v] = p3;
    __syncthreads();
    const int l = tid >> 7;
    float o = (red[(0 * 4 + l) * 128 + v] + red[(1 * 4 + l) * 128 + v] + red[(2 * 4 + l) * 128 + v] + red[(3 * 4 + l) * 128 + v]) * __builtin_amdgcn_exp2f((float)(l + 1) * l2g);
#pragma unroll
    for (int m = 0; m < 4; ++m) o += A[l * 4 + m] * vs[m * 128 + v];
    const float ws1 = wave_sum(o), ws2 = wave_sum(o * o);
    if ((tid & 63) == 0) { st[((tid >> 6)) * 2] = ws1; st[((tid >> 6)) * 2 + 1] = ws2; }
    __syncthreads();
    const int w0 = (tid >> 7) * 2; const float s1 = st[w0 * 2] + st[(w0 + 1) * 2], s2 = st[w0 * 2 + 1] + st[(w0 + 1) * 2 + 1];
    const float mean = s1 * (1.f / 128.f), var = s2 * (1.f / 128.f) - mean * mean, rstd = 1.0f / sqrtf(var + GN_EPS);
    const int row = MPR + b * DS + l; const float gt = bf2f(H[(size_t)row * EIN + 2048 + hh * 128 + v]);
    CAT[(size_t)row * DM + POOLD + hh * 128 + v] = f2bf(silu_f(gt) * ((o - mean) * rstd * gn_g[hh * 128 + v]));
    __syncthreads();
}
__device__ __forceinline__ void mla_norm_pass(const float* q_norm_g, const float* kv_norm_g, float* outp, const float* Z, bf16_t* CQN, bf16_t* CKVN, bf16_t* KF, bf16_t* KPEB, const float* c32t, const float* s32t, int gw, int NGW, int lane) {
    for (int row = gw; row < MV; row += NGW) {
        const float* z = Z + (size_t)row * DM;
        const f32x4 q0 = *(const f32x4*)(z + 4 * lane), q1 = *(const f32x4*)(z + 256 + 4 * lane), kv = *(const f32x4*)(z + 512 + 4 * lane);
        float sq = (q0[0] * q0[0] + q0[1] * q0[1]) + (q0[2] * q0[2] + q0[3] * q0[3]) + (q1[0] * q1[0] + q1[1] * q1[1]) + (q1[2] * q1[2] + q1[3] * q1[3]);
        float sk = (kv[0] * kv[0] + kv[1] * kv[1]) + (kv[2] * kv[2] + kv[3] * kv[3]);
        sq = wave_sum(sq); sk = wave_sum(sk);
        const float rq = 1.0f / sqrtf(sq * (1.f / QL) + RMS_EPS), rk = 1.0f / sqrtf(sk * (1.f / KVL) + RMS_EPS);
        const f32x4 g0 = *(const f32x4*)(q_norm_g + 4 * lane), g1 = *(const f32x4*)(q_norm_g + 256 + 4 * lane), gk = *(const f32x4*)(kv_norm_g + 4 * lane);
        const f32x4 y0 = q0 * rq * g0, y1 = q1 * rq * g1, yk = kv * rk * gk;
        u32x2 w; w.x = pk2(y0[0], y0[1]); w.y = pk2(y0[2], y0[3]); *(u32x2*)(CQN + (size_t)row * QL + 4 * lane) = w;
        w.x = pk2(y1[0], y1[1]); w.y = pk2(y1[2], y1[3]); *(u32x2*)(CQN + (size_t)row * QL + 256 + 4 * lane) = w;
        w.x = pk2(yk[0], yk[1]); w.y = pk2(yk[2], yk[3]); *(u32x2*)(CKVN + (size_t)row * KVL + 4 * lane) = w;
        float* ock = row < MPR ? outp + O_CKVP + (size_t)row * KVL : outp + O_CKVS + (size_t)(row - MPR) * KVL;
        *(f32x4*)(ock + 4 * lane) = yk;
        if (lane < 32) {
            const int tix = row < MPR ? (row & (SEQ - 1)) : SEQ + (row & 3);
            const float x1 = z[768 + lane], x2 = z[800 + lane], c = c32t[tix * 32 + lane], s = s32t[tix * 32 + lane];
            const float y1r = x1 * c - x2 * s, y2r = x2 * c + x1 * s;
            float* okp = row < MPR ? outp + O_KPEP + (size_t)row * ROPE : outp + O_KPES + (size_t)(row - MPR) * ROPE;
            okp[lane] = y1r; okp[32 + lane] = y2r;
            const bf16_t b1 = f2bf(y1r), b2 = f2bf(y2r);
            if (row < MPR) {
#pragma unroll
                for (int h = 0; h < MH; ++h) { bf16_t* p = KF + ((size_t)row * MH + h) * QKD + NOPE; p[lane] = b1; p[32 + lane] = b2; }
            } else { KPEB[(size_t)(row - MPR) * ROPE + lane] = b1; KPEB[(size_t)(row - MPR) * ROPE + 32 + lane] = b2; }
        }
    }
}

constexpr int KP = 400;
constexpr int ATT_STAGE = 64 * KP + 64 * TP;
__device__ __forceinline__ void attn_prompt_unit(int b, int h, int qb, const bf16_t* Q, const bf16_t* KF, const bf16_t* V, bf16_t* O, LAS unsigned char* lds) {
    const int tid = threadIdx.x, lane = tid & 63, wid = tid >> 6, hi = lane >> 5, c32 = lane & 31;
    const int rowb = b * SEQ, q0 = qb * 256, qw = q0 + 32 * wid;
    const int qpos = qw + c32;
    bf16x8 qf[12];
#pragma unroll
    for (int s = 0; s < 12; ++s) qf[s] = *(const bf16x8*)(Q + ((size_t)(rowb + qpos) * MH + h) * QKD + 16 * s + 8 * hi);
    const int NT = (q0 + 256) / 64;
    u32x4 kr[3], vr[2];
    auto gload = [&](int j) {
#pragma unroll
        for (int i = 0; i < 3; ++i) { const int ch = tid + 512 * i, r = ch / 24, cc = ch % 24; kr[i] = *(const u32x4*)(KF + ((size_t)(rowb + 64 * j + r) * MH + h) * QKD + cc * 8); }
#pragma unroll
        for (int i = 0; i < 2; ++i) { const int ch = tid + 512 * i, r = ch >> 4, cc = ch & 15; vr[i] = *(const u32x4*)(V + ((size_t)(rowb + 64 * j + r) * MH + h) * VD + cc * 8); }
    };
    auto swrite = [&](LAS unsigned char* st) {
#pragma unroll
        for (int i = 0; i < 3; ++i) { const int ch = tid + 512 * i, r = ch / 24, cc = ch % 24; *(LAS u32x4*)(st + r * KP + cc * 16) = kr[i]; }
#pragma unroll
        for (int i = 0; i < 2; ++i) { const int ch = tid + 512 * i, r = ch >> 4, cc = ch & 15; *(LAS u32x4*)(st + 64 * KP + r * TP + cc * 16) = vr[i]; }
    };
    f32x16 o[4]; o[0] = f32x16{}; o[1] = f32x16{}; o[2] = f32x16{}; o[3] = f32x16{};
    float mrun = -INFINITY, lrun = 0.f;
    gload(0);
    for (int j = 0; j < NT; ++j) {
        LAS unsigned char* st = lds + (j & 1) * ATT_STAGE;
        swrite(st);
        __syncthreads();
        if (j + 1 < NT) gload(j + 1);
        const LAS unsigned char* Kt = st; const LAS unsigned char* Vt = st + 64 * KP;
#pragma unroll
        for (int half = 0; half < 2; ++half) {
            const int kvh = 64 * j + 32 * half;
            if (kvh <= qw + 31) {
                f32x16 p = {};
#pragma unroll
                for (int sg = 0; sg < 3; ++sg) { bf16x8 kf[4];
#pragma unroll
                    for (int i = 0; i < 4; ++i) kf[i] = frag_row(Kt, KP, 32 * half, 16 * (4 * sg + i), lane);
#pragma unroll
                    for (int i = 0; i < 4; ++i) p = MFMA32(kf[i], qf[4 * sg + i], p);
                    __builtin_amdgcn_sched_barrier(0); }
                if (kvh + 31 > qw) {
#pragma unroll
                    for (int r = 0; r < 16; ++r) { if (kvh + crow(r, hi) > qpos) p[r] = -INFINITY; }
                }
                float mx = p[0];
#pragma unroll
                for (int r = 1; r < 16; ++r) mx = fmaxf(mx, p[r]);
                mx = fmaxf(mx, __shfl_xor(mx, 32));
                const float mnew = fmaxf(mrun, mx), alpha = __builtin_amdgcn_exp2f(mrun - mnew);
                float ps = 0.f;
#pragma unroll
                for (int r = 0; r < 16; ++r) { p[r] = __builtin_amdgcn_exp2f(p[r] - mnew); ps += p[r]; }
                lrun = lrun * alpha + ps; mrun = mnew;
                if (__any(alpha != 1.0f)) {
#pragma unroll
                    for (int cb = 0; cb < 4; ++cb)
#pragma unroll
                        for (int r = 0; r < 16; ++r) o[cb][r] *= alpha;
                }
                const bf16x8 pf0 = acc_frag(p, 0), pf1 = acc_frag(p, 1);
#pragma unroll
                for (int cb = 0; cb < 4; ++cb) {
                    const bf16x8 v0 = frag_tr_acc(Vt, TP, 32 * half, 32 * cb, lane), v1 = frag_tr_acc(Vt, TP, 32 * half + 16, 32 * cb, lane);
                    o[cb] = MFMA32(v0, pf0, o[cb]); o[cb] = MFMA32(v1, pf1, o[cb]);
                    if (cb & 1) __builtin_amdgcn_sched_barrier(0);
                }
            }
        }
    }
    lrun += __shfl_xor(lrun, 32);
    const float inv = 1.0f / lrun;
    bf16_t* orow = O + (size_t)(rowb + qpos) * DM + h * VD;
#pragma unroll
    for (int cb = 0; cb < 4; ++cb)
#pragma unroll
        for (int rg = 0; rg < 4; ++rg) { u32x2 w; w.x = pk2(o[cb][4 * rg] * inv, o[cb][4 * rg + 1] * inv); w.y = pk2(o[cb][4 * rg + 2] * inv, o[cb][4 * rg + 3] * inv);
            *(u32x2*)(orow + 32 * cb + 8 * rg + 4 * hi) = w; }
    __syncthreads();
}

constexpr int SP = 672;
constexpr int PART_LD = 264;
__device__ __forceinline__ void attn_sample_unit(int b, int sp, const int* page_table, const float* cache_ckv, const float* cache_kpe, const bf16_t* Q, const bf16_t* WUKB, float* PART, bf16_t* QLAT, LAS unsigned char* lds) {
    const int tid = threadIdx.x, lane = tid & 63, wid = tid >> 6, hi = lane >> 5, c32 = lane & 31;
    LAS unsigned char* KT0 = lds; LAS unsigned char* QT = lds + 64 * SP;
    {
        const int h = wid;
        bf16x8 bq[8];
#pragma unroll
        for (int s = 0; s < 8; ++s) { bf16x8 z = {}; if (c32 < DS) z = *(const bf16x8*)(Q + ((size_t)(MPR + b * DS + c32) * MH + h) * QKD + 16 * s + 8 * hi); bq[s] = z; }
        for (int ct = 0; ct < 8; ++ct) {
            f32x16 acc = {};
#pragma unroll
            for (int s = 0; s < 8; ++s) { const bf16x8 af = *(const bf16x8*)(WUKB + (size_t)(32 * ct + c32) * 1024 + h * 128 + 16 * s + 8 * hi); acc = MFMA32(af, bq[s], acc); }
            if (c32 < DS) {
#pragma unroll
                for (int rg = 0; rg < 4; ++rg) { u32x2 w; w.x = pk2(acc[4 * rg], acc[4 * rg + 1]); w.y = pk2(acc[4 * rg + 2], acc[4 * rg + 3]);
                    *(LAS u32x2*)(QT + (c32 * 8 + h) * SP + (32 * ct + 8 * rg + 4 * hi) * 2) = w; }
            }
        }
        if (tid < 256) { const int r = tid >> 3, cc = tid & 7, q = r >> 3, hh = r & 7;
            *(LAS u32x4*)(QT + r * SP + 512 + cc * 16) = *(const u32x4*)(Q + ((size_t)(MPR + b * DS + q) * MH + hh) * QKD + NOPE + cc * 8); }
    }
    __syncthreads();
    if (sp == 0) {
        for (int i = tid; i < 32 * 40; i += 512) { const int r = i / 40, cc = i % 40; *(u32x4*)(QLAT + ((size_t)b * 32 + r) * 320 + cc * 8) = *(const LAS u32x4*)(QT + r * SP + cc * 16); }
    }
    f32x16 o = {};
    float mrun = -INFINITY, lrun = 0.f;
    f32x4 cr[4], pr;
#define SA_GLOAD(t) do { const int pid_ = page_table[b * NPG + sp * 16 + ((t) >> 2)]; \
        const f32x4* cp_ = (const f32x4*)(cache_ckv + ((size_t)pid_ * PAGE + ((t) & 3) * 32) * KVL); const f32x4* pp_ = (const f32x4*)(cache_kpe + ((size_t)pid_ * PAGE + ((t) & 3) * 32) * ROPE); \
        _Pragma("unroll") for (int i = 0; i < 4; ++i) cr[i] = __builtin_nontemporal_load(cp_ + tid + 512 * i); \
        pr = __builtin_nontemporal_load(pp_ + tid); } while (0)
    SA_GLOAD(0);
    for (int t = 0; t < 64; ++t) {
        LAS unsigned char* KT = KT0 + (t & 1) * (32 * SP);
#pragma unroll
        for (int i = 0; i < 4; ++i) { const int f = tid + 512 * i, key = f >> 6, c4 = f & 63; u32x2 w; w.x = pk2(cr[i][0], cr[i][1]); w.y = pk2(cr[i][2], cr[i][3]); *(LAS u32x2*)(KT + key * SP + c4 * 8) = w; }
        { const int key = tid >> 4, c4 = tid & 15; u32x2 w; w.x = pk2(pr[0], pr[1]); w.y = pk2(pr[2], pr[3]); *(LAS u32x2*)(KT + key * SP + 512 + c4 * 8) = w; }
        __syncthreads();
        if (t + 1 < 64) SA_GLOAD(t + 1);
        f32x16 x = {};
#pragma unroll
        for (int sg = 0; sg < 5; ++sg) { bf16x8 kf[4], qq[4];
#pragma unroll
            for (int i = 0; i < 4; ++i) { kf[i] = frag_row(KT, SP, 0, 16 * (4 * sg + i), lane); qq[i] = frag_row(QT, SP, 0, 16 * (4 * sg + i), lane); }
#pragma unroll
            for (int i = 0; i < 4; ++i) x = MFMA32(kf[i], qq[i], x);
            __builtin_amdgcn_sched_barrier(0); }
        float mx = x[0];
#pragma unroll
        for (int r = 1; r < 16; ++r) mx = fmaxf(mx, x[r]);
        mx = fmaxf(mx, __shfl_xor(mx, 32));
        const float mnew = fmaxf(mrun, mx), alpha = __builtin_amdgcn_exp2f(mrun - mnew);
        float ps = 0.f;
#pragma unroll
        for (int r = 0; r < 16; ++r) { x[r] = __builtin_amdgcn_exp2f(x[r] - mnew); ps += x[r]; }
        lrun = lrun * alpha + ps; mrun = mnew;
        const bf16x8 pf0 = acc_frag(x, 0), pf1 = acc_frag(x, 1);
#pragma unroll
        for (int r = 0; r < 16; ++r) o[r] *= alpha;
        o = MFMA32(frag_tr_acc(KT, SP, 0, 32 * wid, lane), pf0, o);
        o = MFMA32(frag_tr_acc(KT, SP, 16, 32 * wid, lane), pf1, o);
    }
#undef SA_GLOAD
    lrun += __shfl_xor(lrun, 32);
    float* pp = PART + ((size_t)(b * 8 + sp) * 32) * PART_LD;
#pragma unroll
    for (int r = 0; r < 16; ++r) pp[(size_t)c32 * PART_LD + 32 * wid + crow(r, hi)] = o[r];
    if (wid == 0 && hi == 0) { pp[(size_t)c32 * PART_LD + 256] = mrun; pp[(size_t)c32 * PART_LD + 257] = lrun; }
    __syncthreads();
}

__device__ __forceinline__ void attn_combine_unit(int b, int q, const float* w_uv, const float* PART, const bf16_t* QLAT, const bf16_t* CKVN, const bf16_t* KPEB, bf16_t* O, LAS unsigned char* lds) {
    const int tid = threadIdx.x, lane = tid & 63, h = tid >> 6;
    LAS float* SN = (LAS float*)lds;
    LAS float* OL = SN + 32;
    const int r = q * 8 + h;
    {
        const int kp = lane >> 4, li = lane & 15; float s = 0.f;
        const bf16_t* ql = QLAT + ((size_t)b * 32 + r) * 320; const bf16_t* ck = CKVN + (size_t)(MPR + b * DS + kp) * KVL; const bf16_t* kpe = KPEB + (size_t)(b * DS + kp) * ROPE;
        for (int i = 0; i < 16; ++i) { const int c = li + 16 * i; s += bf2f(ql[c]) * bf2f(ck[c]); }
        for (int i = 0; i < 4; ++i) { const int c = li + 16 * i; s += bf2f(ql[256 + c]) * bf2f(kpe[c]); }
#pragma unroll
        for (int o = 1; o < 16; o <<= 1) s += __shfl_xor(s, o);
        if (li == 0) SN[h * 4 + kp] = (kp <= q) ? s : -INFINITY;
    }
    __syncthreads();
    float ms[8], ls[8], M = -INFINITY;
#pragma unroll
    for (int s = 0; s < 8; ++s) { const float* pp = PART + ((size_t)(b * 8 + s) * 32 + r) * PART_LD; ms[s] = pp[256]; ls[s] = pp[257]; M = fmaxf(M, ms[s]); }
    float sn[4];
#pragma unroll
    for (int k = 0; k < 4; ++k) { sn[k] = SN[h * 4 + k]; M = fmaxf(M, sn[k]); }
    float L = 0.f, wn[4], wsp[8];
#pragma unroll
    for (int s = 0; s < 8; ++s) { wsp[s] = __builtin_amdgcn_exp2f(ms[s] - M); L += ls[s] * wsp[s]; }
#pragma unroll
    for (int k = 0; k < 4; ++k) { wn[k] = __builtin_amdgcn_exp2f(sn[k] - M); L += wn[k]; }
    const float invL = 1.0f / L;
#pragma unroll
    for (int i = 0; i < 4; ++i) { const int c = lane + 64 * i; float acc = 0.f;
#pragma unroll
        for (int s = 0; s < 8; ++s) acc += wsp[s] * PART[((size_t)(b * 8 + s) * 32 + r) * PART_LD + c];
#pragma unroll
        for (int k = 0; k < 4; ++k) acc += wn[k] * bf2f(CKVN[(size_t)(MPR + b * DS + k) * KVL + c]);
        OL[h * 256 + c] = acc * invL; }
    __syncthreads();
    float o0 = 0.f, o1 = 0.f; const float* wv = w_uv + h * 128 + lane;
#pragma unroll 4
    for (int c = 0; c < 256; ++c) { const float ol = OL[h * 256 + c]; o0 += ol * wv[(size_t)c * 1024]; o1 += ol * wv[(size_t)c * 1024 + 64]; }
    bf16_t* orow = O + (size_t)(MPR + b * DS + q) * DM + h * 128;
    orow[lane] = f2bf(o0); orow[lane + 64] = f2bf(o1);
    __syncthreads();
}
constexpr int LDS_BYTES = 147456;
constexpr size_t WS_WUKB = WS_END;
constexpr size_t WS_TOTAL = WS_WUKB + (size_t)KVL * 1024 * 2;

constexpr int ARGS_OFF = 131072 + 256;

__global__ void __launch_bounds__(512, 2) fwd_kernel(Args a) {
    extern __shared__ __attribute__((aligned(16))) unsigned char lds_raw[];
    LAS unsigned char* lds = (LAS unsigned char*)lds_raw;
    cg::grid_group grid = cg::this_grid();
    const int tid = threadIdx.x, lane = tid & 63, wave = tid >> 6, G = gridDim.x, bx = blockIdx.x;
    const int gw = bx * 8 + wave, NGW = G * 8, gtid = bx * 512 + tid, gsz = G * 512;
    const int lo = a.ph_lo, hi = a.ph_hi;
    LAS unsigned* sa = (LAS unsigned*)(lds + ARGS_OFF);
    if (tid == 0) {
        LAS unsigned long long* sp = (LAS unsigned long long*)sa;
#define X(T, n) sp[AI_##n] = (unsigned long long)a.n;
        ARG_LIST(X)
#undef X
    }
    __syncthreads();
#define LP(n) ldarg<decltype(Args::n)>(sa, AI_##n)
#define WSP(T, off) ((T*)(LP(ws) + (off)))
#ifndef PH_MASK
#define PH_MASK 0xffffffffu
#endif
#define IN(k) (((PH_MASK >> (k)) & 1u) && lo <= (k) && (k) < hi)
#define SEAM(k) do { if (IN(k) && IN((k) + 1)) grid.sync(); } while (0)
#define GEMM(Aptr, lda_, Bptr, ldb_, N_, K_, EPI) do { int k_ = K_; asm volatile("" : "+s"(k_)); pg8::Gemm g_{Aptr, Bptr, lda_, ldb_, MP, N_, k_}; pg8::StaticOrder S_; S_.init(MP, N_, G, bx); pg8::gemm_phase(lds, g_, S_, EPI); } while (0)
#define TABS float* c64 = WSP(float, WS_TAB); float* s64 = c64 + NPOS * 64; float* c32t = s64 + NPOS * 64; float* s32t = c32t + NPOS * 32

    if (IN(0)) {
        p0_prologue(a, lds, gw, NGW, lane, gtid, gsz);
        bf16_t* WUKB = WSP(bf16_t, WS_WUKB);
        for (int e = gtid; e < KVL * 1024 / 4; e += gsz) { const f32x4 v = *((const f32x4*)a.w_uk + e); u32x2 w; w.x = pk2(v[0], v[1]); w.y = pk2(v[2], v[3]); *((u32x2*)WUKB + e) = w; }
    }
    SEAM(0);
    if (IN(1)) { TABS; (void)c32t; (void)s32t; epi::EpiIn E{WSP(bf16_t, WS_H), c64, s64}; GEMM(WSP(bf16_t, WS_X0), DM, WSP(bf16_t, WS_WIN), DM, EIN, DM, E); }
    SEAM(1);
    if (IN(2)) {
        const bf16_t* H = WSP(bf16_t, WS_H); bf16_t* CAT = WSP(bf16_t, WS_CAT);
        pool_pass(LP(state_pool), LP(out), H, CAT, gtid, gsz);
        float* KVLOC = WSP(float, WS_KVLOC);
        for (int u = bx; u < 512; u += G) ret_r1_unit(u, H, KVLOC, lds);
        for (int u = G - 1 - bx; u < 128; u += G) ret_sample_unit(u, LP(state_ret), LP(out), LP(gn_g), H, CAT, lds);
    }
    SEAM(2);
    if (IN(3)) ret_scan_pass(WSP(float, WS_KVLOC), WSP(bf16_t, WS_STB), LP(out) + O_RETP, gtid, gsz);
    SEAM(3);
    if (IN(4)) { const float* gn = LP(gn_g); const bf16_t* H = WSP(bf16_t, WS_H); const bf16_t* STB = WSP(bf16_t, WS_STB); bf16_t* CAT = WSP(bf16_t, WS_CAT);
        for (int u = bx; u < 512; u += G) ret_r3_unit(u, gn, H, STB, CAT, lds); }
    SEAM(4);
    if (IN(5)) { epi::EpiZ E{WSP(float, WS_Z), DM, WSP(bf16_t, WS_X0), DM, ALPHA}; GEMM(WSP(bf16_t, WS_CAT), DM, WSP(bf16_t, WS_WCAT), DM, DM, DM, E); }
    SEAM(5);
    if (IN(6)) ln_pass(WSP(float, WS_Z), LP(ln_mix_g), LP(ln_mix_b), WSP(bf16_t, WS_X1), nullptr, nullptr, gw, NGW, lane);
    SEAM(6);
    if (IN(7)) { float* o = LP(out); epi::EpiUp E{WSP(bf16_t, WS_AB), WSP(bf16_t, WS_BB), o + O_CONVP, o + O_CONVS}; GEMM(WSP(bf16_t, WS_X1), DM, WSP(bf16_t, WS_WUP0), DM, 2 * FF, DM, E); }
    SEAM(7);
    if (IN(8)) conv_gate_pass(WSP(bf16_t, WS_AB), WSP(bf16_t, WS_BB), WSP(bf16_t, WS_G), LP(conv_w), LP(conv_b), LP(state_conv), gtid, gsz);
    SEAM(8);
    if (IN(9)) { epi::EpiZ E{WSP(float, WS_Z), DM, WSP(bf16_t, WS_X1), DM, ALPHA}; GEMM(WSP(bf16_t, WS_G), FF, WSP(bf16_t, WS_WDN0), FF, DM, FF, E); }
    SEAM(9);
    if (IN(10)) ln_pass(WSP(float, WS_Z), LP(ln_ffn_g), LP(ln_ffn_b), WSP(bf16_t, WS_X0), nullptr, nullptr, gw, NGW, lane);
    SEAM(10);
    if (IN(11)) { epi::EpiZ E{WSP(float, WS_Z), DM, nullptr, 0, 0.f}; GEMM(WSP(bf16_t, WS_X0), DM, WSP(bf16_t, WS_WDQKV), DM, DM, DM, E); }
    SEAM(11);
    if (IN(12)) { TABS; (void)c64; (void)s64; mla_norm_pass(LP(q_norm_g), LP(kv_norm_g), LP(out), WSP(float, WS_Z), WSP(bf16_t, WS_CQN), WSP(bf16_t, WS_CKVN), WSP(bf16_t, WS_KF), WSP(bf16_t, WS_KPEB), c32t, s32t, gw, NGW, lane); }
    SEAM(12);
    if (IN(13)) {
#if !defined(G13_ONLY) || G13_ONLY == 1
        { TABS; (void)c64; (void)s64; epi::EpiUq E{WSP(bf16_t, WS_Q), c32t, s32t}; GEMM(WSP(bf16_t, WS_CQN), QL, WSP(bf16_t, WS_WUQ), QL, 1536, QL, E); }
#endif
#if !defined(G13_ONLY) || G13_ONLY == 2
        { epi::EpiUkv E{WSP(bf16_t, WS_KF), WSP(bf16_t, WS_V)}; GEMM(WSP(bf16_t, WS_CKVN), KVL, WSP(bf16_t, WS_WUKV), KVL, 2048, KVL, E); }
#endif
    }
    SEAM(13);
    if (IN(14)) {
        const bf16_t* Q = WSP(bf16_t, WS_Q);
#if !defined(ATT_ONLY) || ATT_ONLY == 1
        { const bf16_t* KF = WSP(bf16_t, WS_KF); const bf16_t* V = WSP(bf16_t, WS_V); bf16_t* O = WSP(bf16_t, WS_CAT);
        for (int u = bx; u < 256; u += G) { const int bh = u >> 2, pi = u & 3; attn_prompt_unit(bh >> 3, bh & 7, 7 - pi, Q, KF, V, O, lds); attn_prompt_unit(bh >> 3, bh & 7, pi, Q, KF, V, O, lds); } }
#endif
#if !defined(ATT_ONLY) || ATT_ONLY == 2
        { const int* pt = LP(page_table); const float* cck = LP(cache_ckv); const float* ckp = LP(cache_kpe); const bf16_t* WUKB = WSP(bf16_t, WS_WUKB); float* PART = WSP(float, WS_PART); bf16_t* QLAT = WSP(bf16_t, WS_QLAT);
        for (int u = bx; u < 256; u += G) attn_sample_unit(u >> 3, u & 7, pt, cck, ckp, Q, WUKB, PART, QLAT, lds); }
#endif
    }
    SEAM(14);
    if (IN(15)) { const float* wuv = LP(w_uv); const float* PART = WSP(float, WS_PART); const bf16_t* QLAT = WSP(bf16_t, WS_QLAT); const bf16_t* CKVN = WSP(bf16_t, WS_CKVN); const bf16_t* KPEB = WSP(bf16_t, WS_KPEB); bf16_t* O = WSP(bf16_t, WS_CAT);
        for (int u = bx; u < 128; u += G) attn_combine_unit(u >> 2, u & 3, wuv, PART, QLAT, CKVN, KPEB, O, lds); }
    SEAM(15);
    if (IN(16)) { epi::EpiZ E{WSP(float, WS_Z), DM, WSP(bf16_t, WS_X0), DM, ALPHA}; GEMM(WSP(bf16_t, WS_CAT), DM, WSP(bf16_t, WS_WOM), DM, DM, DM, E); }
    SEAM(16);
    if (IN(17)) ln_pass(WSP(float, WS_Z), LP(ln_mix_g) + DM, LP(ln_mix_b) + DM, WSP(bf16_t, WS_X1), nullptr, nullptr, gw, NGW, lane);
    SEAM(17);
    if (IN(18)) { float* o = LP(out); epi::EpiUp E{WSP(bf16_t, WS_AB), WSP(bf16_t, WS_BB), o + O_CONVP + (size_t)NB * 2 * FF, o + O_CONVS + (size_t)DB * 2 * FF}; GEMM(WSP(bf16_t, WS_X1), DM, WSP(bf16_t, WS_WUP1), DM, 2 * FF, DM, E); }
    SEAM(18);
    if (IN(19)) conv_gate_pass(WSP(bf16_t, WS_AB), WSP(bf16_t, WS_BB), WSP(bf16_t, WS_G), LP(conv_w) + 3 * FF, LP(conv_b) + FF, LP(state_conv) + (size_t)DB * 2 * FF, gtid, gsz);
    SEAM(19);
    if (IN(20)) { epi::EpiZ E{WSP(float, WS_Z), DM, WSP(bf16_t, WS_X1), DM, ALPHA}; GEMM(WSP(bf16_t, WS_G), FF, WSP(bf16_t, WS_WDN1), FF, DM, FF, E); }
    SEAM(20);
    if (IN(21)) { float* o = LP(out); ln_pass(WSP(float, WS_Z), LP(ln_ffn_g) + DM, LP(ln_ffn_b) + DM, nullptr, o + O_YP, o + O_YS, gw, NGW, lane); }
#undef IN
#undef SEAM
#undef GEMM
#undef LP
#undef WSP
#undef TABS
}

constexpr int N_PHASES = 22;
#ifndef MK_SPLIT
#define MK_SPLIT 0
#endif

extern "C" void kernel_launch(void* const* d_in, const int* in_sizes, int n_in, void* d_out, int out_size, void* d_ws, size_t ws_size, hipStream_t stream) {
    static int grid = 0;
    if (grid == 0) {
        int dev = 0, cus = 0, per_cu = 0;
        (void)hipGetDevice(&dev);
        (void)hipDeviceGetAttribute(&cus, hipDeviceAttributeMultiprocessorCount, dev);
        (void)hipFuncSetAttribute((const void*)fwd_kernel, hipFuncAttributeMaxDynamicSharedMemorySize, LDS_BYTES);
        (void)hipOccupancyMaxActiveBlocksPerMultiprocessor(&per_cu, (const void*)fwd_kernel, 512, LDS_BYTES);
        if (n_in != 29 || (size_t)out_size != O_END || ws_size < WS_TOTAL) fprintf(stderr, "kernel_launch: unexpected sizes n_in %d out %d (want %zu) ws %zu (want %zu)\n", n_in, out_size, (size_t)O_END, ws_size, (size_t)WS_TOTAL);
        if (per_cu < 1) { fprintf(stderr, "kernel_launch: occupancy query says %d blocks/CU\n", per_cu); per_cu = 1; }
        grid = cus;
        (void)hipGetLastError();
    }
    Args a{};
    a.x_prompt = (const float*)d_in[0]; a.x_sample = (const float*)d_in[1]; a.state_pool = (const float*)d_in[2]; a.state_ret = (const float*)d_in[3];
    a.cache_ckv = (const float*)d_in[4]; a.cache_kpe = (const float*)d_in[5]; a.state_conv = (const float*)d_in[6]; a.page_table = (const int*)d_in[7];
    a.w_in = (const float*)d_in[8]; a.pool_w = (const float*)d_in[9]; a.pool_scale = (const float*)d_in[10]; a.gn_g = (const float*)d_in[11]; a.w_o_even = (const float*)d_in[12];
    a.w_dq = (const float*)d_in[13]; a.q_norm_g = (const float*)d_in[14]; a.w_uq = (const float*)d_in[15]; a.w_dkv = (const float*)d_in[16]; a.kv_norm_g = (const float*)d_in[17];
    a.w_uk = (const float*)d_in[18]; a.w_uv = (const float*)d_in[19]; a.w_o_mla = (const float*)d_in[20]; a.w_up = (const float*)d_in[21]; a.conv_w = (const float*)d_in[22];
    a.conv_b = (const float*)d_in[23]; a.w_down = (const float*)d_in[24]; a.ln_mix_g = (const float*)d_in[25]; a.ln_mix_b = (const float*)d_in[26]; a.ln_ffn_g = (const float*)d_in[27]; a.ln_ffn_b = (const float*)d_in[28];
    a.out = (float*)d_out; a.ws = (unsigned char*)d_ws; a.dbg = 0; a.pad = 0;
#if MK_SPLIT
    for (int p = 0; p < N_PHASES; ++p) { a.ph_lo = p; a.ph_hi = p + 1; void* args[] = {&a};
        hipError_t e = hipLaunchCooperativeKernel((const void*)fwd_kernel, dim3(grid), dim3(512), args, LDS_BYTES, stream);
        if (e != hipSuccess) { fprintf(stderr, "launch %d failed: %s\n", p, hipGetErrorString(e)); break; } }
#else
    a.ph_lo = 0; a.ph_hi = N_PHASES; void* args[] = {&a};
    hipError_t e = hipLaunchCooperativeKernel((const void*)fwd_kernel, dim3(grid), dim3(512), args, LDS_BYTES, stream);
    if (e != hipSuccess) fprintf(stderr, "cooperative launch failed: %s (grid %d)\n", hipGetErrorString(e), grid);
#endif
}
```

```cpp
#include <hip/hip_runtime.h>
#include <hip/hip_cooperative_groups.h>
#include <cstdio>
#include <cstdint>
namespace cg = cooperative_groups;

#define LAS __attribute__((address_space(3)))
typedef unsigned short bf16_t;
typedef short bf16x8 __attribute__((ext_vector_type(8)));
typedef short s16x4 __attribute__((ext_vector_type(4)));
typedef float f32x4 __attribute__((ext_vector_type(4)));
typedef float f32x2 __attribute__((ext_vector_type(2)));
typedef float f32x16 __attribute__((ext_vector_type(16)));
typedef unsigned u32x4 __attribute__((ext_vector_type(4)));
typedef unsigned u32x2 __attribute__((ext_vector_type(2)));
typedef __bf16 bf16x2_t __attribute__((ext_vector_type(2)));

__device__ __forceinline__ unsigned pk2(float lo, float hi) { f32x2 v = {lo, hi}; bf16x2_t b = __builtin_convertvector(v, bf16x2_t); return __builtin_bit_cast(unsigned, b); }
__device__ __forceinline__ float bf_lo(unsigned w) { return __uint_as_float(w << 16); }
__device__ __forceinline__ float bf_hi(unsigned w) { return __uint_as_float(w & 0xffff0000u); }
__device__ __forceinline__ float bf2f(bf16_t h) { return __uint_as_float(((unsigned)h) << 16); }
__device__ __forceinline__ bf16_t f2bf(float f) { return (bf16_t)(pk2(f, 0.f) & 0xffffu); }
__device__ __forceinline__ float wave_sum(float v) {
#pragma unroll
    for (int o = 1; o < 64; o <<= 1) v += __shfl_xor(v, o);
    return v;
}
__device__ __forceinline__ float silu_f(float x) { return x / (1.0f + __expf(-x)); }

constexpr int DM = 1024, NB = 8, SEQ = 2048, DB = 32, DS = 4, PAST = 16384, PAGE = 128, NPG = PAST / PAGE;
constexpr int MPR = NB * SEQ;
constexpr int MS = DB * DS;
constexpr int MV = MPR + MS;
constexpr int MP = 65 * 256;
constexpr int POOLD = 512, HIST = 15, RH = 4, RD = 128;
constexpr int EIN = 2560, FF = 2816;
constexpr int MH = 8, NOPE = 128, ROPE = 64, VD = 128, QL = 512, KVL = 256, QKD = NOPE + ROPE;
constexpr float ALPHA = 1.4142135623730951f;
constexpr float LN_EPS = 1e-5f, RMS_EPS = 1e-6f, GN_EPS = 1e-6f;
constexpr float LOG2E = 1.4426950408889634f;
constexpr float QSCALE = 0.07216878364870322f * LOG2E;
constexpr int NPOS = SEQ + DS;

namespace pg8 {
constexpr int BM = 256, BK = 64, HALF = 128, HTB = HALF * BK * 2, STAGE_BYTES = 8 * HTB, NXCD = 8, WGM = 8;
__host__ __device__ __forceinline__ int lds_byte(int r, int c) { const int st = (r >> 4) * 2 + (c >> 5), rr = r & 15, cc = c & 31, ob = rr * 64 + cc * 2; return st * 1024 + (ob ^ (((ob >> 9) & 1) << 5)); }
__host__ __device__ __forceinline__ void stage_rc(int b, int& R, int& C) { const int st = b / 1024, sb = b % 1024, swz = sb ^ (((sb >> 9) & 1) << 5); R = (st >> 1) * 16 + swz / 64; C = (st & 1) * 32 + (swz % 64) / 2; }

struct Unit { int pm, pn; };
struct Gemm { const bf16_t* A; const bf16_t* Bt; int lda, ldb, M, N, K; };

struct StaticOrder {
    int nM, nN, nwg, G, c;
    __host__ __device__ void init(int M, int N, int G_, int c_) { nM = M / BM; nN = N / BM; nwg = nM * nN; G = G_; c = c_; }
    __host__ __device__ bool next(int i, Unit& u) const {
        const long L = (long)i * G + c; if (L >= nwg) return false;
        int wgid = (int)L; { const int q = nwg / NXCD, r = nwg % NXCD, xcd = wgid % NXCD, off = wgid / NXCD; wgid = (xcd < r ? xcd * (q + 1) : r * (q + 1) + (xcd - r) * q) + off; }
        const int nig = WGM * nN, gid = wgid / nig, fm = gid * WGM, gsz = (nM - fm) < WGM ? (nM - fm) : WGM;
        u.pm = fm + ((wgid % nig) % gsz); u.pn = (wgid % nig) / gsz; return true;
    }
};

template <class Epi, bool ALIGN_EPI = true>
__device__ __forceinline__ void gemm_phase(LAS unsigned char* lds, const Gemm g, const StaticOrder& S, const Epi& E) {
    const int tid = threadIdx.x, wid = __builtin_amdgcn_readfirstlane(tid >> 6), lane = tid & 63, wr = wid >> 2, wc = wid & 3, fr = lane & 15, fq = lane >> 4;
    const int K = g.K, nt = K / BK;
    unsigned voffA[2], voffB[2];
#pragma unroll
    for (int i = 0; i < 2; ++i) { int R, C; stage_rc(tid * 16 + i * 8192, R, C);
        voffA[i] = (unsigned)(R * g.lda + C) * 2u; voffB[i] = (unsigned)(R * g.ldb + C) * 2u; }
    const size_t kstep = (size_t)(BK * 2);
    const size_t hstepA = (size_t)HALF * g.lda * 2, hstepB = (size_t)HALF * g.ldb * 2;
    const unsigned ldsw = (unsigned)wid * 1024u;
    const int aoff = lds_byte(wr * 64 + fr, fq * 8), boff = lds_byte(wc * 32 + fr, fq * 8);
#define PG8_SA(b, h) (((b) * 2 + (h)) * HTB)
#define PG8_SB(b, h) ((4 + (b) * 2 + (h)) * HTB)
#define PG8_STAGE(bufoff, gbase, voff) do { _Pragma("unroll") for (int _i = 0; _i < 2; ++_i) \
        __builtin_amdgcn_global_load_lds((const unsigned*)((const char*)(gbase) + (voff)[_i]), (LAS unsigned*)(lds + (bufoff) + ldsw + _i * 8192), 16, 0, 0); } while (0)
#define PG8_LDA(dst, b, h) do { _Pragma("unroll") for (int m = 0; m < 4; ++m) _Pragma("unroll") for (int k = 0; k < 2; ++k) dst[m][k] = *(const LAS bf16x8*)(lds + PG8_SA(b, h) + aoff + m * 2048 + k * 1024); } while (0)
#define PG8_LDB(dst, b, h) do { _Pragma("unroll") for (int n = 0; n < 2; ++n) _Pragma("unroll") for (int k = 0; k < 2; ++k) dst[n][k] = *(const LAS bf16x8*)(lds + PG8_SB(b, h) + boff + n * 2048 + k * 1024); } while (0)
#define PG8_MMA(ai, bj, At, Bt) do { __builtin_amdgcn_s_setprio(1); _Pragma("unroll") for (int m = 0; m < 4; ++m) _Pragma("unroll") for (int n = 0; n < 2; ++n) _Pragma("unroll") for (int k = 0; k < 2; ++k) \
        acc[ai][bj][m][n] = __builtin_amdgcn_mfma_f32_16x16x32_bf16(Bt[n][k], At[m][k], acc[ai][bj][m][n], 0, 0, 0); __builtin_amdgcn_s_setprio(0); } while (0)
#define PG8_WAIT_V(n) asm volatile("s_waitcnt vmcnt(" #n ")" ::: "memory")
#define PG8_WAIT_L(n) asm volatile("s_waitcnt lgkmcnt(" #n ")" ::: "memory")
#define PG8_BAR __builtin_amdgcn_s_barrier()
#define PG8_SCHED __builtin_amdgcn_sched_barrier(0)
    Unit cur, nxt; int ui = 0;
    if (!S.next(0, cur)) return;
    f32x4 acc[2][2][4][2];
#pragma unroll
    for (int a = 0; a < 2; ++a)
#pragma unroll
        for (int b = 0; b < 2; ++b)
#pragma unroll
            for (int m = 0; m < 4; ++m)
#pragma unroll
                for (int n = 0; n < 2; ++n) acc[a][b][m][n] = (f32x4){0.f, 0.f, 0.f, 0.f};
    bf16x8 At[4][2], B0[2][2], B1[2][2];
    const char* cA = (const char*)g.A + (size_t)cur.pm * 2 * hstepA; const char* cB = (const char*)g.Bt + (size_t)cur.pn * 2 * hstepB;
    PG8_STAGE(PG8_SB(0, 0), cB, voffB); PG8_STAGE(PG8_SB(0, 1), cB + hstepB, voffB); PG8_STAGE(PG8_SA(0, 0), cA, voffA); PG8_STAGE(PG8_SA(0, 1), cA + hstepA, voffA);
    if (wr == 1) PG8_BAR;
    PG8_WAIT_V(2); PG8_BAR;
    PG8_STAGE(PG8_SB(1, 0), cB + kstep, voffB); PG8_STAGE(PG8_SA(1, 0), cA + kstep, voffA); PG8_STAGE(PG8_SB(1, 1), cB + hstepB + kstep, voffB);
    PG8_WAIT_V(6); PG8_BAR;
    for (;;) {
        const bool has_next = S.next(ui + 1, nxt);
        const char* nA = has_next ? (const char*)g.A + (size_t)nxt.pm * 2 * hstepA : cA; const char* nB = has_next ? (const char*)g.Bt + (size_t)nxt.pn * 2 * hstepB : cB;
        for (int t = 0; t < nt; t += 2) {
            const bool last = (t == nt - 2);
            const char* a1 = cA + (size_t)(t + 1) * kstep;
            const char* a2 = last ? nA : cA + (size_t)(t + 2) * kstep; const char* b2 = last ? nB : cB + (size_t)(t + 2) * kstep;
            const char* a3 = a2 + kstep; const char* b3 = b2 + kstep;
            PG8_LDB(B0, 0, 0); PG8_LDB(B1, 0, 1); PG8_SCHED; PG8_LDA(At, 0, 0); PG8_STAGE(PG8_SA(1, 1), a1 + hstepA, voffA);
            PG8_WAIT_V(8); PG8_WAIT_L(0); PG8_BAR; PG8_MMA(0, 0, At, B0); PG8_MMA(0, 1, At, B1); PG8_BAR; PG8_SCHED;
            PG8_LDA(At, 0, 1); PG8_STAGE(PG8_SB(0, 0), b2, voffB); PG8_STAGE(PG8_SB(0, 1), b2 + hstepB, voffB); PG8_STAGE(PG8_SA(0, 0), a2, voffA);
            PG8_WAIT_V(8); PG8_WAIT_L(0); PG8_BAR; PG8_MMA(1, 0, At, B0); PG8_MMA(1, 1, At, B1); PG8_BAR; PG8_SCHED;
            PG8_LDB(B0, 1, 0); PG8_LDB(B1, 1, 1); PG8_SCHED; PG8_LDA(At, 1, 0); PG8_STAGE(PG8_SA(0, 1), a2 + hstepA, voffA);
            PG8_WAIT_V(8); PG8_WAIT_L(0); PG8_BAR; PG8_MMA(0, 0, At, B0); PG8_MMA(0, 1, At, B1); PG8_BAR; PG8_SCHED;
            PG8_LDA(At, 1, 1); PG8_STAGE(PG8_SB(1, 0), b3, voffB); PG8_STAGE(PG8_SB(1, 1), b3 + hstepB, voffB); PG8_STAGE(PG8_SA(1, 0), a3, voffA);
            PG8_WAIT_V(8); PG8_WAIT_L(0); PG8_BAR; PG8_MMA(1, 0, At, B0); PG8_MMA(1, 1, At, B1); PG8_BAR; PG8_SCHED;
        }
        if constexpr (ALIGN_EPI) { if (wr == 0) PG8_BAR; }
        E(acc, cur, wr, wc, fr, fq);
        if (!has_next) break;
#pragma unroll
        for (int a = 0; a < 2; ++a)
#pragma unroll
            for (int b = 0; b < 2; ++b)
#pragma unroll
                for (int m = 0; m < 4; ++m)
#pragma unroll
                    for (int n = 0; n < 2; ++n) acc[a][b][m][n] = (f32x4){0.f, 0.f, 0.f, 0.f};
        cur = nxt; cA = nA; cB = nB; ++ui;
        if constexpr (ALIGN_EPI) { if (wr == 1) PG8_BAR; }
    }
    PG8_WAIT_V(0);
    if constexpr (!ALIGN_EPI) { if (wr == 0) PG8_BAR; }
    PG8_BAR;
#undef PG8_SA
#undef PG8_SB
#undef PG8_STAGE
#undef PG8_LDA
#undef PG8_LDB
#undef PG8_MMA
#undef PG8_WAIT_V
#undef PG8_WAIT_L
#undef PG8_BAR
#undef PG8_SCHED
}
}
namespace epi {
using pg8::Unit;
__device__ __forceinline__ int tix_of_row(int row) { return row < MPR ? (row & (SEQ - 1)) : (row < MV ? SEQ + (row & (DS - 1)) : 0); }

struct EpiIn {
    bf16_t* H; const float* cos64; const float* sin64;
    __device__ __forceinline__ void operator()(const f32x4 (&acc)[2][2][4][2], const Unit& u, int wr, int wc, int fr, int fq) const {
        const int type = u.pn >> 1;
        if (type == 1 || type == 2) {
            const float sc = (type == 2) ? 0.08838834764831845f : 1.0f;
            const int i0 = 16 * wc + 4 * fq;
#pragma unroll
            for (int ai = 0; ai < 2; ++ai)
#pragma unroll
                for (int m = 0; m < 4; ++m) {
                    const int row = u.pm * 256 + ai * 128 + wr * 64 + m * 16 + fr; const int tix = tix_of_row(row);
                    const f32x4 c = *(const f32x4*)(cos64 + tix * 64 + i0), s = *(const f32x4*)(sin64 + tix * 64 + i0);
#pragma unroll
                    for (int bj = 0; bj < 2; ++bj) {
                        const f32x4 x1 = acc[ai][bj][m][0], x2 = acc[ai][bj][m][1];
                        const f32x4 y1 = (x1 * c - x2 * s) * sc, y2 = (x2 * c + x1 * s) * sc;
                        bf16_t* p = H + (size_t)row * EIN + u.pn * 256 + bj * 128 + i0;
                        u32x2 w1, w2; w1.x = pk2(y1[0], y1[1]); w1.y = pk2(y1[2], y1[3]); w2.x = pk2(y2[0], y2[1]); w2.y = pk2(y2[2], y2[3]);
                        *(u32x2*)p = w1; *(u32x2*)(p + 64) = w2;
                    }
                    asm volatile("" ::: "memory");
                }
        } else {
#pragma unroll
            for (int ai = 0; ai < 2; ++ai)
#pragma unroll
                for (int m = 0; m < 4; ++m) {
                    const int row = u.pm * 256 + ai * 128 + wr * 64 + m * 16 + fr;
#pragma unroll
                    for (int bj = 0; bj < 2; ++bj) {
                        const f32x4 v0 = acc[ai][bj][m][0], v1 = acc[ai][bj][m][1];
                        u32x4 w; w.x = pk2(v0[0], v0[1]); w.y = pk2(v0[2], v0[3]); w.z = pk2(v1[0], v1[1]); w.w = pk2(v1[2], v1[3]);
                        *(u32x4*)(H + (size_t)row * EIN + u.pn * 256 + bj * 128 + wc * 32 + 8 * fq) = w;
                    }
                }
        }
    }
};

struct EpiZ {
    float* Z; int ldz; const bf16_t* res; int ldr; float alpha;
    __device__ __forceinline__ void operator()(const f32x4 (&acc)[2][2][4][2], const Unit& u, int wr, int wc, int fr, int fq) const {
#pragma unroll
        for (int ai = 0; ai < 2; ++ai)
#pragma unroll
            for (int m = 0; m < 4; ++m) {
                const int row = u.pm * 256 + ai * 128 + wr * 64 + m * 16 + fr;
#pragma unroll
                for (int bj = 0; bj < 2; ++bj)
#pragma unroll
                    for (int n = 0; n < 2; ++n) {
                        const int col = u.pn * 256 + bj * 128 + wc * 32 + n * 16 + 4 * fq;
                        f32x4 v = acc[ai][bj][m][n];
                        if (res) { const u32x2 r = *(const u32x2*)(res + (size_t)row * ldr + col); v[0] += alpha * bf_lo(r.x); v[1] += alpha * bf_hi(r.x); v[2] += alpha * bf_lo(r.y); v[3] += alpha * bf_hi(r.y); }
                        *(f32x4*)(Z + (size_t)row * ldz + col) = v;
                    }
            }
    }
};

struct EpiUp {
    bf16_t* Ab; bf16_t* Bb; float* conv_p; float* conv_s;
    __device__ __forceinline__ void operator()(const f32x4 (&acc)[2][2][4][2], const Unit& u, int wr, int wc, int fr, int fq) const {
#pragma unroll
        for (int ai = 0; ai < 2; ++ai)
#pragma unroll
            for (int m = 0; m < 4; ++m) {
                const int row = u.pm * 256 + ai * 128 + wr * 64 + m * 16 + fr;
                const int f0 = u.pn * 128 + wc * 32 + 8 * fq;
                const f32x4 a0 = acc[ai][0][m][0], a1 = acc[ai][0][m][1], b0 = acc[ai][1][m][0], b1 = acc[ai][1][m][1];
                u32x4 wa, wb; wa.x = pk2(a0[0], a0[1]); wa.y = pk2(a0[2], a0[3]); wa.z = pk2(a1[0], a1[1]); wa.w = pk2(a1[2], a1[3]);
                wb.x = pk2(b0[0], b0[1]); wb.y = pk2(b0[2], b0[3]); wb.z = pk2(b1[0], b1[1]); wb.w = pk2(b1[2], b1[3]);
                *(u32x4*)(Ab + (size_t)row * FF + f0) = wa; *(u32x4*)(Bb + (size_t)row * FF + f0) = wb;
                float* o = nullptr;
                if (row < MPR) { const int t = row & (SEQ - 1); if (t >= SEQ - 2) o = conv_p + ((size_t)(row >> 11) * 2 + (t - (SEQ - 2))) * FF + f0; }
                else if (row < MV) { const int t = row & 3; if (t >= 2) o = conv_s + ((size_t)((row - MPR) >> 2) * 2 + (t - 2)) * FF + f0; }
                if (o) { *(f32x4*)o = a0; *(f32x4*)(o + 4) = a1; }
            }
    }
};

struct EpiUq {
    bf16_t* Q; const float* cos32; const float* sin32;
    __device__ __forceinline__ void operator()(const f32x4 (&acc)[2][2][4][2], const Unit& u, int wr, int wc, int fr, int fq) const {
        if (u.pn < 4) {
#pragma unroll
            for (int ai = 0; ai < 2; ++ai)
#pragma unroll
                for (int m = 0; m < 4; ++m) {
                    const int row = u.pm * 256 + ai * 128 + wr * 64 + m * 16 + fr;
#pragma unroll
                    for (int bj = 0; bj < 2; ++bj) {
                        const f32x4 v0 = acc[ai][bj][m][0] * QSCALE, v1 = acc[ai][bj][m][1] * QSCALE;
                        u32x4 w; w.x = pk2(v0[0], v0[1]); w.y = pk2(v0[2], v0[3]); w.z = pk2(v1[0], v1[1]); w.w = pk2(v1[2], v1[3]);
                        *(u32x4*)(Q + ((size_t)row * MH + (2 * u.pn + bj)) * QKD + wc * 32 + 8 * fq) = w;
                    }
                }
        } else {
            const int i0 = 16 * (wc & 1) + 4 * fq;
#pragma unroll
            for (int ai = 0; ai < 2; ++ai)
#pragma unroll
                for (int m = 0; m < 4; ++m) {
                    const int row = u.pm * 256 + ai * 128 + wr * 64 + m * 16 + fr; const int tix = tix_of_row(row);
                    const f32x4 c = *(const f32x4*)(cos32 + tix * 32 + i0), s = *(const f32x4*)(sin32 + tix * 32 + i0);
#pragma unroll
                    for (int bj = 0; bj < 2; ++bj) {
                        const int h = 4 * (u.pn - 4) + 2 * bj + (wc >> 1);
                        const f32x4 x1 = acc[ai][bj][m][0], x2 = acc[ai][bj][m][1];
                        const f32x4 y1 = (x1 * c - x2 * s) * QSCALE, y2 = (x2 * c + x1 * s) * QSCALE;
                        bf16_t* p = Q + ((size_t)row * MH + h) * QKD + NOPE + i0;
                        u32x2 w1, w2; w1.x = pk2(y1[0], y1[1]); w1.y = pk2(y1[2], y1[3]); w2.x = pk2(y2[0], y2[1]); w2.y = pk2(y2[2], y2[3]);
                        *(u32x2*)p = w1; *(u32x2*)(p + 32) = w2;
                    }
                    asm volatile("" ::: "memory");
                }
        }
    }
};

struct EpiUkv {
    bf16_t* KF; bf16_t* V;
    __device__ __forceinline__ void operator()(const f32x4 (&acc)[2][2][4][2], const Unit& u, int wr, int wc, int fr, int fq) const {
        const bool isk = u.pn < 4; bf16_t* base = isk ? KF : V; const int hp = isk ? QKD : VD; const int h0 = 2 * (isk ? u.pn : u.pn - 4);
        const int row0 = u.pm * 256 + wr * 64 + fr;
        bf16_t* p0 = base + ((size_t)row0 * MH + h0) * hp + wc * 32 + 8 * fq;
#pragma unroll
        for (int ai = 0; ai < 2; ++ai)
#pragma unroll
            for (int m = 0; m < 4; ++m) {
#pragma unroll
                for (int bj = 0; bj < 2; ++bj) {
                    const f32x4 v0 = acc[ai][bj][m][0], v1 = acc[ai][bj][m][1];
                    u32x4 w; w.x = pk2(v0[0], v0[1]); w.y = pk2(v0[2], v0[3]); w.z = pk2(v1[0], v1[1]); w.w = pk2(v1[2], v1[3]);
                    *(u32x4*)(p0 + ((size_t)(ai * 128 + m * 16) * MH + bj) * hp) = w;
                }
            }
    }
};
}
constexpr size_t MiB = 1u << 20;
constexpr size_t al(size_t x) { return (x + 255) & ~(size_t)255; }
constexpr size_t WS_CTL = 0;
constexpr size_t WS_WIN = 1 * MiB;
constexpr size_t WS_WCAT = WS_WIN + (size_t)EIN * DM * 2;
constexpr size_t WS_WUP0 = WS_WCAT + (size_t)DM * DM * 2;
constexpr size_t WS_WUP1 = WS_WUP0 + (size_t)2 * FF * DM * 2;
constexpr size_t WS_WDN0 = WS_WUP1 + (size_t)2 * FF * DM * 2;
constexpr size_t WS_WDN1 = WS_WDN0 + (size_t)DM * FF * 2;
constexpr size_t WS_WDQKV = WS_WDN1 + (size_t)DM * FF * 2;
constexpr size_t WS_WUQ = WS_WDQKV + (size_t)DM * DM * 2;
constexpr size_t WS_WUKV = WS_WUQ + (size_t)1536 * QL * 2;
constexpr size_t WS_WOM = WS_WUKV + (size_t)2048 * KVL * 2;
constexpr size_t WS_TAB = WS_WOM + (size_t)DM * DM * 2;
constexpr size_t TAB64 = (size_t)NPOS * 64 * 4, TAB32 = (size_t)NPOS * 32 * 4;
constexpr size_t WS_X0 = al(WS_TAB + 2 * TAB64 + 2 * TAB32);
constexpr size_t WS_X1 = WS_X0 + (size_t)MP * DM * 2;
constexpr size_t WS_CAT = WS_X1 + (size_t)MP * DM * 2;
constexpr size_t WS_Z = WS_CAT + (size_t)MP * DM * 2;
constexpr size_t WS_H = WS_Z + (size_t)MP * DM * 4;
constexpr size_t WS_AB = WS_H + (size_t)MP * EIN * 2;
constexpr size_t WS_BB = WS_AB + (size_t)MP * FF * 2;
constexpr size_t WS_G = WS_BB + (size_t)MP * FF * 2;
constexpr size_t WS_KVLOC = WS_G + (size_t)MP * FF * 2;
constexpr size_t WS_STB = WS_KVLOC + (size_t)512 * 128 * 128 * 4;
constexpr size_t WS_CQN = WS_STB + (size_t)512 * 128 * 128 * 2;
constexpr size_t WS_CKVN = WS_CQN + (size_t)MP * QL * 2;
constexpr size_t WS_KPEB = WS_CKVN + (size_t)MP * KVL * 2;
constexpr size_t WS_Q = al(WS_KPEB + (size_t)MS * ROPE * 2);
constexpr size_t WS_KF = WS_Q + (size_t)MP * MH * QKD * 2;
constexpr size_t WS_V = WS_KF + (size_t)MP * MH * QKD * 2;
constexpr size_t WS_PART = WS_V + (size_t)MP * MH * VD * 2;
constexpr size_t WS_QLAT = WS_PART + (size_t)DB * 8 * 32 * 264 * 4;
constexpr size_t WS_END = WS_QLAT + (size_t)DB * 32 * 320 * 4;

constexpr size_t O_YP = 0;
constexpr size_t O_YS = O_YP + (size_t)MPR * DM;
constexpr size_t O_POOLP = O_YS + (size_t)MS * DM;
constexpr size_t O_POOLS = O_POOLP + (size_t)NB * HIST * POOLD;
constexpr size_t O_RETP = O_POOLS + (size_t)DB * HIST * POOLD;
constexpr size_t O_RETS = O_RETP + (size_t)NB * RH * RD * RD;
constexpr size_t O_CKVP = O_RETS + (size_t)DB * RH * RD * RD;
constexpr size_t O_CKVS = O_CKVP + (size_t)MPR * KVL;
constexpr size_t O_KPEP = O_CKVS + (size_t)MS * KVL;
constexpr size_t O_KPES = O_KPEP + (size_t)MPR * ROPE;
constexpr size_t O_CONVP = O_KPES + (size_t)MS * ROPE;
constexpr size_t O_CONVS = O_CONVP + (size_t)2 * NB * 2 * FF;
constexpr size_t O_END = O_CONVS + (size_t)2 * DB * 2 * FF;

#define ARG_LIST(X) \
    X(const float*, x_prompt) X(const float*, x_sample) X(const float*, state_pool) X(const float*, state_ret) X(const float*, cache_ckv) X(const float*, cache_kpe) X(const float*, state_conv) X(const int*, page_table) \
    X(const float*, w_in) X(const float*, pool_w) X(const float*, pool_scale) X(const float*, gn_g) X(const float*, w_o_even) X(const float*, w_dq) X(const float*, q_norm_g) X(const float*, w_uq) X(const float*, w_dkv) \
    X(const float*, kv_norm_g) X(const float*, w_uk) X(const float*, w_uv) X(const float*, w_o_mla) X(const float*, w_up) X(const float*, conv_w) X(const float*, conv_b) X(const float*, w_down) \
    X(const float*, ln_mix_g) X(const float*, ln_mix_b) X(const float*, ln_ffn_g) X(const float*, ln_ffn_b) X(float*, out) X(unsigned char*, ws)
struct Args {
#define X(T, n) T n;
    ARG_LIST(X)
#undef X
    int ph_lo, ph_hi; int dbg, pad;
};
enum ArgIdx {
#define X(T, n) AI_##n,
    ARG_LIST(X)
#undef X
    AI_COUNT
};
template <class T> __device__ __forceinline__ T ldarg(const LAS unsigned* sa, int idx) {
    const unsigned lo = __builtin_amdgcn_readfirstlane(sa[2 * idx]), hi = __builtin_amdgcn_readfirstlane(sa[2 * idx + 1]);
    return (T)(((unsigned long long)hi << 32) | lo);
}

__device__ __forceinline__ int map_a(int p) { return (p & 96) + 8 * ((p >> 2) & 3) + 4 * ((p >> 4) & 1) + (p & 3); }
__device__ __forceinline__ int map_r64(int p) { return 64 * ((p >> 4) & 1) + 16 * (p >> 5) + 4 * ((p >> 2) & 3) + (p & 3); }

struct FIn { const float* w; __device__ __forceinline__ float operator()(int k, int P) const { const int pn = P >> 8, ty = pn >> 1, p = P & 127; const int L = (P & ~127) + ((ty == 1 || ty == 2) ? map_r64(p) : map_a(p)); return w[(size_t)k * EIN + L]; } };
__device__ __forceinline__ void fold_item(const float* wo, const float* pw, const float* ps, bf16_t* WT, int item, int lane) {
    const int kt = item >> 5, nt = item & 31, k0 = 32 * kt, n0 = 32 * nt, g = k0 >> 7, i = lane & 31, kh = lane >> 5;
    const float* ap = pw + (size_t)(k0 + i) * 128 + kh;
    const float* sp = ps + g * 128 + kh;
    const float* bp = wo + (size_t)(g * 128 + kh) * DM + n0 + i;
    f32x16 acc = {};
#pragma unroll 1
    for (int s0 = 0; s0 < 64; s0 += 16) {
        float av[16], bv[16], sv[16];
#pragma unroll
        for (int j = 0; j < 16; ++j) { av[j] = ap[2 * (s0 + j)]; sv[j] = sp[2 * (s0 + j)]; bv[j] = bp[(size_t)(2 * (s0 + j)) * DM]; }
#pragma unroll
        for (int j = 0; j < 16; ++j) acc = __builtin_amdgcn_mfma_f32_32x32x2f32(av[j] * sv[j], bv[j], acc, 0, 0, 0);
    }
#pragma unroll
    for (int rg = 0; rg < 4; ++rg) { u32x2 w; w.x = pk2(acc[4 * rg], acc[4 * rg + 1]); w.y = pk2(acc[4 * rg + 2], acc[4 * rg + 3]);
        *(u32x2*)(WT + (size_t)(n0 + i) * DM + k0 + 8 * rg + 4 * kh) = w; }
}
struct FUp { const float* w; __device__ __forceinline__ float operator()(int k, int P) const { const int pn = P >> 8, bj = (P >> 7) & 1; return w[(size_t)k * (2 * FF) + (bj ? FF : 0) + pn * 128 + map_a(P & 127)]; } };
struct FNat { const float* w; int ldw; __device__ __forceinline__ float operator()(int k, int P) const { return w[(size_t)k * ldw + P]; } };
struct FDqkv { const float *wdq, *wdkv; __device__ __forceinline__ float operator()(int k, int P) const { return P < QL ? wdq[(size_t)k * QL + P] : (P < QL + KVL + ROPE ? wdkv[(size_t)k * (KVL + ROPE) + (P - QL)] : 0.f); } };
struct FUq { const float* w; __device__ __forceinline__ float operator()(int k, int P) const {
    int src;
    if (P < 1024) { src = (P >> 7) * QKD + map_a(P & 127); }
    else { const int Pp = P - 1024, pn = Pp >> 8, bj = (Pp >> 7) & 1, p = Pp & 127, wc = p >> 5, n = (p >> 4) & 1, fq = (p >> 2) & 3, j = p & 3;
        src = (4 * pn + 2 * bj + (wc >> 1)) * QKD + NOPE + 32 * n + 16 * (wc & 1) + 4 * fq + j; }
    return w[(size_t)k * (MH * QKD) + src]; } };
struct FUkv { const float *wuk, *wuv; __device__ __forceinline__ float operator()(int k, int P) const { const int Pp = P & 1023; const float* w = P < 1024 ? wuk : wuv; return w[(size_t)k * 1024 + (Pp >> 7) * 128 + map_a(Pp & 127)]; } };

template <class F>
__device__ __forceinline__ void tr_item(const F& f, int K, bf16_t* WT, LAS float* scr, int item, int nblk, int lane) {
    const int kb = item / nblk, nb = item % nblk, k0 = 64 * kb, n0 = 32 * nb;
    float tv[32];
#pragma unroll
    for (int i = 0; i < 32; ++i) tv[i] = f(k0 + 2 * i + (lane >> 5), n0 + (lane & 31));
#pragma unroll
    for (int i = 0; i < 32; ++i) scr[(2 * i + (lane >> 5)) * 33 + (lane & 31)] = tv[i];
    asm volatile("s_waitcnt lgkmcnt(0)" ::: "memory");
    const int c = lane & 7;
#pragma unroll
    for (int j = 0; j < 4; ++j) { const int n = (lane >> 3) + 8 * j; const LAS float* s = scr + (8 * c) * 33 + n;
        u32x4 o; o.x = pk2(s[0 * 33], s[1 * 33]); o.y = pk2(s[2 * 33], s[3 * 33]); o.z = pk2(s[4 * 33], s[5 * 33]); o.w = pk2(s[6 * 33], s[7 * 33]);
        *(u32x4*)(WT + (size_t)(n0 + n) * K + k0 + 8 * c) = o; }
    asm volatile("s_waitcnt lgkmcnt(0)" ::: "memory");
}

__device__ __forceinline__ void sincos_d(double ang, float& c, float& s) {
    const double TWO_PI = 6.283185307179586476925286766559, INV_TWO_PI = 0.15915494309189533576888376337251;
    const double n = __builtin_rint(ang * INV_TWO_PI); const double r = ang - n * TWO_PI; const double r2 = r * r;
    double tc = 1.0, ts = r, sc = 1.0, ss = r;
#pragma unroll
    for (int k = 1; k <= 14; ++k) { tc *= r2 * (-1.0 / (double)((2 * k - 1) * (2 * k))); ts *= r2 * (-1.0 / (double)((2 * k) * (2 * k + 1))); sc += tc; ss += ts; }
    c = (float)sc; s = (float)ss;
}
__device__ __forceinline__ double ipow_d(double b, int e) { double r = 1.0;
#pragma unroll
    for (int i = 0; i < 6; ++i) { if (e & 1) r *= b; b *= b; e >>= 1; }
    return r; }

__device__ __forceinline__ void p0_prologue(const Args& a, LAS unsigned char* lds, int gw, int NGW, int lane, int gtid, int gsz) {
    unsigned char* ws = a.ws;
    LAS float* scr = (LAS float*)(lds + (threadIdx.x >> 6) * 8704);
    constexpr int I_IN = 16 * 80, I_CAT = 8 * 32, I_FOLD = 512, I_UP = 16 * 176, I_DN = 44 * 32, I_DQKV = 16 * 32, I_UQ = 8 * 48, I_UKV = 4 * 64, I_OM = 16 * 32;
    constexpr int NIT = I_FOLD + I_IN + I_CAT + 2 * I_UP + 2 * I_DN + I_DQKV + I_UQ + I_UKV + I_OM;
    for (int it = gw; it < NIT; it += NGW) {
        int r = it;
        if (r < I_FOLD) { fold_item(a.w_o_even, a.pool_w, a.pool_scale, (bf16_t*)(ws + WS_WCAT), r, lane); continue; } r -= I_FOLD;
        if (r < I_CAT) { tr_item(FNat{a.w_o_even + (size_t)POOLD * DM, DM}, DM, (bf16_t*)(ws + WS_WCAT) + POOLD, scr, r, 32, lane); continue; } r -= I_CAT;
        if (r < I_IN) { tr_item(FIn{a.w_in}, DM, (bf16_t*)(ws + WS_WIN), scr, r, 80, lane); continue; } r -= I_IN;
        if (r < I_UP) { tr_item(FUp{a.w_up}, DM, (bf16_t*)(ws + WS_WUP0), scr, r, 176, lane); continue; } r -= I_UP;
        if (r < I_UP) { tr_item(FUp{a.w_up + (size_t)DM * 2 * FF}, DM, (bf16_t*)(ws + WS_WUP1), scr, r, 176, lane); continue; } r -= I_UP;
        if (r < I_DN) { tr_item(FNat{a.w_down, DM}, FF, (bf16_t*)(ws + WS_WDN0), scr, r, 32, lane); continue; } r -= I_DN;
        if (r < I_DN) { tr_item(FNat{a.w_down + (size_t)FF * DM, DM}, FF, (bf16_t*)(ws + WS_WDN1), scr, r, 32, lane); continue; } r -= I_DN;
        if (r < I_DQKV) { tr_item(FDqkv{a.w_dq, a.w_dkv}, DM, (bf16_t*)(ws + WS_WDQKV), scr, r, 32, lane); continue; } r -= I_DQKV;
        if (r < I_UQ) { tr_item(FUq{a.w_uq}, QL, (bf16_t*)(ws + WS_WUQ), scr, r, 48, lane); continue; } r -= I_UQ;
        if (r < I_UKV) { tr_item(FUkv{a.w_uk, a.w_uv}, KVL, (bf16_t*)(ws + WS_WUKV), scr, r, 64, lane); continue; } r -= I_UKV;
        tr_item(FNat{a.w_o_mla, DM}, DM, (bf16_t*)(ws + WS_WOM), scr, r, 32, lane);
    }
    bf16_t* X0 = (bf16_t*)(ws + WS_X0);
    for (int row0 = gw * 2; row0 < MP; row0 += NGW * 2) {
        f32x4 v[2][4];
#pragma unroll
        for (int rr = 0; rr < 2; ++rr) { const int row = row0 + rr; const float* src = row < MPR ? a.x_prompt + (size_t)row * DM : (row < MV ? a.x_sample + (size_t)(row - MPR) * DM : nullptr);
#pragma unroll
            for (int j = 0; j < 4; ++j) v[rr][j] = src ? *(const f32x4*)(src + 256 * j + 4 * lane) : (f32x4){0.f, 0.f, 0.f, 0.f}; }
#pragma unroll
        for (int rr = 0; rr < 2; ++rr)
#pragma unroll
            for (int j = 0; j < 4; ++j) { u32x2 w; w.x = pk2(v[rr][j][0], v[rr][j][1]); w.y = pk2(v[rr][j][2], v[rr][j][3]); *(u32x2*)(X0 + (size_t)(row0 + rr) * DM + 256 * j + 4 * lane) = w; }
    }
    float* c64 = (float*)(ws + WS_TAB); float* s64 = c64 + NPOS * 64; float* c32 = s64 + NPOS * 64; float* s32 = c32 + NPOS * 32;
    for (int e = gtid; e < NPOS * 96; e += gsz) {
        const int tix = e / 96, i = e % 96; const double pos = tix < SEQ ? (double)tix : (double)(PAST + tix - SEQ);
        const bool is64 = i < 64; const int ii = is64 ? i : i - 64; const double rr = is64 ? 0.8659643233600653523531691834 : 0.7498942093324558273021842756;
        const double inv = ipow_d(rr, ii);
        float c, s; sincos_d(pos * inv, c, s);
        if (is64) { c64[tix * 64 + ii] = c; s64[tix * 64 + ii] = s; } else { c32[tix * 32 + ii] = c; s32[tix * 32 + ii] = s; }
    }
}

__device__ __forceinline__ void ln_pass(const float* Z, const float* g, const float* b, bf16_t* X, float* outp, float* outs, int gw, int NGW, int lane) {
    for (int row = gw; row < MV; row += NGW) {
        const float* z = Z + (size_t)row * DM; f32x4 v[4]; float s = 0.f;
#pragma unroll
        for (int j = 0; j < 4; ++j) { v[j] = *(const f32x4*)(z + 256 * j + 4 * lane); s += (v[j][0] + v[j][1]) + (v[j][2] + v[j][3]); }
        const float mean = wave_sum(s) * (1.f / DM); float q = 0.f;
#pragma unroll
        for (int j = 0; j < 4; ++j) { v[j] = v[j] - mean; q += (v[j][0] * v[j][0] + v[j][1] * v[j][1]) + (v[j][2] * v[j][2] + v[j][3] * v[j][3]); }
        const float rstd = 1.0f / sqrtf(wave_sum(q) * (1.f / DM) + LN_EPS);
        float* o = outp ? (row < MPR ? outp + (size_t)row * DM : outs + (size_t)(row - MPR) * DM) : nullptr;
#pragma unroll
        for (int j = 0; j < 4; ++j) { const f32x4 gg = *(const f32x4*)(g + 256 * j + 4 * lane), bb = *(const f32x4*)(b + 256 * j + 4 * lane);
            const f32x4 y = v[j] * rstd * gg + bb;
            if (X) { u32x2 w; w.x = pk2(y[0], y[1]); w.y = pk2(y[2], y[3]); *(u32x2*)(X + (size_t)row * DM + 256 * j + 4 * lane) = w; }
            if (o) *(f32x4*)(o + 256 * j + 4 * lane) = y; }
    }
}

__device__ __forceinline__ void load8(const bf16_t* p, float (&v)[8]) { const u32x4 w = *(const u32x4*)p; v[0] = bf_lo(w.x); v[1] = bf_hi(w.x); v[2] = bf_lo(w.y); v[3] = bf_hi(w.y); v[4] = bf_lo(w.z); v[5] = bf_hi(w.z); v[6] = bf_lo(w.w); v[7] = bf_hi(w.w); }
__device__ __forceinline__ void load8f(const float* p, float (&v)[8]) { const f32x4 a = *(const f32x4*)p, b = *(const f32x4*)(p + 4); v[0] = a[0]; v[1] = a[1]; v[2] = a[2]; v[3] = a[3]; v[4] = b[0]; v[5] = b[1]; v[6] = b[2]; v[7] = b[3]; }
__device__ __forceinline__ void store8(bf16_t* p, const float (&v)[8]) { u32x4 w; w.x = pk2(v[0], v[1]); w.y = pk2(v[2], v[3]); w.z = pk2(v[4], v[5]); w.w = pk2(v[6], v[7]); *(u32x4*)p = w; }

template <int RB>
__device__ __forceinline__ void conv_gate_block(const bf16_t* Ab, const bf16_t* Bb, bf16_t* G, const float* cw, const float* cb, int row0, int f0, const float* h2p, const float* h1p, bool has_prev) {
    float w0[8], w1[8], w2[8], c0[8];
    load8f(cw + f0, w0); load8f(cw + FF + f0, w1); load8f(cw + 2 * FF + f0, w2); load8f(cb + f0, c0);
    u32x4 ar[RB + 2], br[RB];
#pragma unroll
    for (int i = 0; i < RB; ++i) { ar[i + 2] = *(const u32x4*)(Ab + (size_t)(row0 + i) * FF + f0); br[i] = *(const u32x4*)(Bb + (size_t)(row0 + i) * FF + f0); }
    float p2[8], p1[8];
    if (has_prev) { ar[0] = *(const u32x4*)(Ab + (size_t)(row0 - 2) * FF + f0); ar[1] = *(const u32x4*)(Ab + (size_t)(row0 - 1) * FF + f0); }
    else if (h2p) { load8f(h2p, p2); load8f(h1p, p1); ar[0].x = pk2(p2[0], p2[1]); ar[0].y = pk2(p2[2], p2[3]); ar[0].z = pk2(p2[4], p2[5]); ar[0].w = pk2(p2[6], p2[7]); ar[1].x = pk2(p1[0], p1[1]); ar[1].y = pk2(p1[2], p1[3]); ar[1].z = pk2(p1[4], p1[5]); ar[1].w = pk2(p1[6], p1[7]); }
    else { ar[0] = (u32x4){0u, 0u, 0u, 0u}; ar[1] = (u32x4){0u, 0u, 0u, 0u}; }
#pragma unroll
    for (int i = 0; i < RB; ++i) {
        float a0[8], a1[8], a2[8], bb[8], o[8];
        { const u32x4 w = ar[i + 2]; a0[0] = bf_lo(w.x); a0[1] = bf_hi(w.x); a0[2] = bf_lo(w.y); a0[3] = bf_hi(w.y); a0[4] = bf_lo(w.z); a0[5] = bf_hi(w.z); a0[6] = bf_lo(w.w); a0[7] = bf_hi(w.w); }
        { const u32x4 w = ar[i + 1]; a1[0] = bf_lo(w.x); a1[1] = bf_hi(w.x); a1[2] = bf_lo(w.y); a1[3] = bf_hi(w.y); a1[4] = bf_lo(w.z); a1[5] = bf_hi(w.z); a1[6] = bf_lo(w.w); a1[7] = bf_hi(w.w); }
        { const u32x4 w = ar[i]; a2[0] = bf_lo(w.x); a2[1] = bf_hi(w.x); a2[2] = bf_lo(w.y); a2[3] = bf_hi(w.y); a2[4] = bf_lo(w.z); a2[5] = bf_hi(w.z); a2[6] = bf_lo(w.w); a2[7] = bf_hi(w.w); }
        { const u32x4 w = br[i]; bb[0] = bf_lo(w.x); bb[1] = bf_hi(w.x); bb[2] = bf_lo(w.y); bb[3] = bf_hi(w.y); bb[4] = bf_lo(w.z); bb[5] = bf_hi(w.z); bb[6] = bf_lo(w.w); bb[7] = bf_hi(w.w); }
        if (!has_prev && h2p) { if (i == 0) {
#pragma unroll
                for (int j = 0; j < 8; ++j) { a2[j] = p2[j]; a1[j] = p1[j]; } } else if (i == 1) {
#pragma unroll
                for (int j = 0; j < 8; ++j) a2[j] = p1[j]; } }
#pragma unroll
        for (int j = 0; j < 8; ++j) { const float cv = c0[j] + w0[j] * a2[j] + w1[j] * a1[j] + w2[j] * a0[j]; o[j] = silu_f(cv) * bb[j]; }
        store8(G + (size_t)(row0 + i) * FF + f0, o);
    }
}
__device__ __forceinline__ void conv_gate_pass(const bf16_t* Ab, const bf16_t* Bb, bf16_t* G, const float* cw, const float* cb, const float* sconv  , int gtid, int gsz) {
    constexpr int CH = FF / 8, RB = 8, NPB = MPR / RB;
    for (int it = gtid; it < NPB * CH; it += gsz) {
        const int rb = it / CH, f0 = (it % CH) * 8, row0 = rb * RB;
        conv_gate_block<RB>(Ab, Bb, G, cw, cb, row0, f0, nullptr, nullptr, (row0 & (SEQ - 1)) != 0);
    }
    for (int it = gtid; it < DB * CH; it += gsz) {
        const int b = it / CH, f0 = (it % CH) * 8; const float* hb = sconv + (size_t)b * 2 * FF + f0;
        conv_gate_block<DS>(Ab, Bb, G, cw, cb, MPR + b * DS, f0, hb, hb + FF, false);
    }
}
typedef short v4i16_t __attribute__((ext_vector_type(4)));
__device__ __forceinline__ s16x4 tr4(const LAS unsigned char* p) { return __builtin_bit_cast(s16x4, __builtin_amdgcn_ds_read_tr16_b64_v4i16((LAS v4i16_t*)p)); }
__device__ __forceinline__ bf16x8 frag_tr(const LAS unsigned char* tile, int pitch, int k0, int n0, int lane) {
    const int h = lane >> 5, blk = (lane >> 4) & 1, q = (lane & 15) >> 2, p = lane & 3;
    const LAS unsigned char* base = tile + (k0 + 8 * h + q) * pitch + (n0 + 16 * blk + 4 * p) * 2;
    const s16x4 lo = tr4(base), hi = tr4(base + 4 * pitch);
    return (bf16x8){lo[0], lo[1], lo[2], lo[3], hi[0], hi[1], hi[2], hi[3]};
}
__device__ __forceinline__ bf16x8 frag_tr_acc(const LAS unsigned char* tile, int pitch, int k0, int n0, int lane) {
    const int h = lane >> 5, blk = (lane >> 4) & 1, q = (lane & 15) >> 2, p = lane & 3;
    const LAS unsigned char* base = tile + (k0 + 4 * h + q) * pitch + (n0 + 16 * blk + 4 * p) * 2;
    const s16x4 lo = tr4(base), hi = tr4(base + 8 * pitch);
    return (bf16x8){lo[0], lo[1], lo[2], lo[3], hi[0], hi[1], hi[2], hi[3]};
}
__device__ __forceinline__ bf16x8 frag_row(const LAS unsigned char* tile, int pitch, int r0, int k0, int lane) {
    return *(const LAS bf16x8*)(tile + (r0 + (lane & 31)) * pitch + (k0 + 8 * (lane >> 5)) * 2);
}
__device__ __forceinline__ int crow(int r, int hi) { return (r & 3) + 8 * (r >> 2) + 4 * hi; }
__device__ __forceinline__ bf16x8 acc_frag(const f32x16& x, int s) {
    u32x4 w; w.x = pk2(x[8 * s + 0], x[8 * s + 1]); w.y = pk2(x[8 * s + 2], x[8 * s + 3]); w.z = pk2(x[8 * s + 4], x[8 * s + 5]); w.w = pk2(x[8 * s + 6], x[8 * s + 7]);
    return __builtin_bit_cast(bf16x8, w);
}
#define MFMA32(a, b, c) __builtin_amdgcn_mfma_f32_32x32x16_bf16((a), (b), (c), 0, 0, 0)

__device__ __forceinline__ float log2gamma(int h) { return h == 0 ? -0.04580368961312479f : (h == 1 ? -0.02272007650008353f : (h == 2 ? -0.011315313227834147f : -0.005646563141142062f)); }

constexpr int TP = 288;

__device__ __forceinline__ void pool_pass(const float* state_pool, float* outp, const bf16_t* H, bf16_t* CAT, int gtid, int gsz) {
    for (int it = gtid; it < MV * 64; it += gsz) {
        const int row = it >> 6, ch0 = (it & 63) * 8, w = 2 << (ch0 >> 7);
        float u0[8], s[8], t8[8];
        load8(H + (size_t)row * EIN + ch0, u0);
#pragma unroll
        for (int j = 0; j < 8; ++j) s[j] = u0[j];
        float cnt;
        if (row < MPR) { const int t = row & (SEQ - 1); const int n = (w < t + 1) ? w : t + 1; cnt = (float)n;
            for (int q = 1; q < n; ++q) { load8(H + (size_t)(row - q) * EIN + ch0, t8);
#pragma unroll
                for (int j = 0; j < 8; ++j) s[j] += t8[j]; } }
        else { const int t = row & 3, b = (row - MPR) >> 2; cnt = (float)w;
            for (int q = 1; q < w; ++q) { const int e = HIST + t - q;
                if (e >= HIST) load8(H + (size_t)(row - q) * EIN + ch0, t8); else load8f(state_pool + ((size_t)b * HIST + e) * POOLD + ch0, t8);
#pragma unroll
                for (int j = 0; j < 8; ++j) s[j] += t8[j]; } }
        const float ic = 1.0f / cnt;
#pragma unroll
        for (int j = 0; j < 8; ++j) s[j] = s[j] * ic - u0[j];
        store8(CAT + (size_t)row * DM + ch0, s);
    }
    for (int it = gtid; it < (NB + DB) * HIST * 64; it += gsz) {
        const int ch0 = (it & 63) * 8, ri = it >> 6; float v[8];
        if (ri < NB * HIST) { const int b = ri / HIST, i = ri % HIST; load8(H + (size_t)(b * SEQ + SEQ - HIST + i) * EIN + ch0, v);
            float* o = outp + O_POOLP + (size_t)ri * POOLD + ch0; *(f32x4*)o = (f32x4){v[0], v[1], v[2], v[3]}; *(f32x4*)(o + 4) = (f32x4){v[4], v[5], v[6], v[7]}; }
        else { const int r2 = ri - NB * HIST, b = r2 / HIST, i = r2 % HIST;
            if (i < HIST - DS) load8f(state_pool + ((size_t)b * HIST + DS + i) * POOLD + ch0, v); else load8(H + (size_t)(MPR + b * DS + i - (HIST - DS)) * EIN + ch0, v);
            float* o = outp + O_POOLS + (size_t)r2 * POOLD + ch0; *(f32x4*)o = (f32x4){v[0], v[1], v[2], v[3]}; *(f32x4*)(o + 4) = (f32x4){v[4], v[5], v[6], v[7]}; }
    }
}

__device__ __forceinline__ void ret_r1_unit(int unit, const bf16_t* H, float* KVLOC, LAS unsigned char* lds) {
    const int tid = threadIdx.x, lane = tid & 63, wid = tid >> 6, hh = unit & 3, bc = unit >> 2; const int row0 = bc * 128;
    const float l2g = log2gamma(hh);
    LAS unsigned char* Kt = lds; LAS unsigned char* Vt = lds + 128 * TP;
#pragma unroll
    for (int i = 0; i < 4; ++i) { const int ch = tid + 512 * i, r = ch >> 4, cc = ch & 15;
        const bf16_t* src = H + (size_t)(row0 + r) * EIN + hh * 128 + cc * 8;
        const u32x4 vv = *(const u32x4*)(src + 1536); float kk[8]; load8(src + 1024, kk);
        const float kd = __builtin_amdgcn_exp2f((float)(127 - r) * l2g);
#pragma unroll
        for (int j = 0; j < 8; ++j) kk[j] *= kd;
        u32x4 kw; kw.x = pk2(kk[0], kk[1]); kw.y = pk2(kk[2], kk[3]); kw.z = pk2(kk[4], kk[5]); kw.w = pk2(kk[6], kk[7]);
        *(LAS u32x4*)(Kt + r * TP + cc * 16) = kw; *(LAS u32x4*)(Vt + r * TP + cc * 16) = vv; }
    __syncthreads();
    const int vb = wid >> 1, db0 = 2 * (wid & 1);
    f32x16 acc0 = {}, acc1 = {};
#pragma unroll
    for (int ks = 0; ks < 8; ++ks) {
        const bf16x8 af = frag_tr(Vt, TP, 16 * ks, 32 * vb, lane);
        const bf16x8 b0 = frag_tr(Kt, TP, 16 * ks, 32 * db0, lane), b1 = frag_tr(Kt, TP, 16 * ks, 32 * (db0 + 1), lane);
        acc0 = MFMA32(af, b0, acc0); acc1 = MFMA32(af, b1, acc1);
    }
    float* o = KVLOC + (size_t)unit * 16384; const int hi = lane >> 5, c32 = lane & 31;
#pragma unroll
    for (int r = 0; r < 16; ++r) { const int v = 32 * vb + crow(r, hi); o[v * 128 + 32 * db0 + c32] = acc0[r]; o[v * 128 + 32 * (db0 + 1) + c32] = acc1[r]; }
    __syncthreads();
}

__device__ __forceinline__ void ret_scan_pass(const float* KVLOC, bf16_t* STB, float* out_retp, int gtid, int gsz) {
    for (int e = gtid; e < NB * RH * 16384; e += gsz) {
        const int vd = e & 16383, hh = (e >> 14) & 3, b = e >> 16; const float g128 = __builtin_amdgcn_exp2f(128.0f * log2gamma(hh));
        float s = 0.f;
#pragma unroll 4
        for (int c = 0; c < 16; ++c) { const size_t idx = ((size_t)((b * 16 + c) * 4 + hh)) * 16384 + vd; STB[idx] = f2bf(s); s = g128 * s + KVLOC[idx]; }
        const int v = vd >> 7, d = vd & 127;
        out_retp[((size_t)(b * RH + hh) * RD + d) * RD + v] = s;
    }
}

__device__ __forceinline__ void ret_r3_unit(int unit, const float* gn_g, const bf16_t* H, const bf16_t* STB, bf16_t* CAT, LAS unsigned char* lds) {
    const int tid = threadIdx.x, lane = tid & 63, wid = tid >> 6, hh = unit & 3, bc = unit >> 2; const int row0 = bc * 128;
    const int hi = lane >> 5, c32 = lane & 31; const float l2g = log2gamma(hh);
    LAS unsigned char* Kt = lds; LAS unsigned char* Vt = lds + 128 * TP; LAS float* red = (LAS float*)(lds + 256 * TP);
#pragma unroll
    for (int i = 0; i < 4; ++i) { const int ch = tid + 512 * i, r = ch >> 4, cc = ch & 15;
        const bf16_t* src = H + (size_t)(row0 + r) * EIN + hh * 128 + cc * 8;
        *(LAS u32x4*)(Kt + r * TP + cc * 16) = *(const u32x4*)(src + 1024); *(LAS u32x4*)(Vt + r * TP + cc * 16) = *(const u32x4*)(src + 1536); }
    const int lb = wid & 3, vh = wid >> 2; const int lq = 32 * lb + c32;
    bf16x8 qf[8];
#pragma unroll
    for (int s = 0; s < 8; ++s) qf[s] = *(const bf16x8*)(H + (size_t)(row0 + lq) * EIN + 512 + hh * 128 + 16 * s + 8 * hi);
    __syncthreads();
    f32x16 o0 = {}, o1 = {};
    for (int mb = 0; mb <= lb; ++mb) {
        f32x16 x = {};
#pragma unroll
        for (int s = 0; s < 8; ++s) x = MFMA32(frag_row(Kt, TP, 32 * mb, 16 * s, lane), qf[s], x);
#pragma unroll
        for (int r = 0; r < 16; ++r) { const int dl = lq - (32 * mb + crow(r, hi)); x[r] = dl >= 0 ? x[r] * __builtin_amdgcn_exp2f((float)dl * l2g) : 0.f; }
#pragma unroll
        for (int s2 = 0; s2 < 2; ++s2) { const bf16x8 pf = acc_frag(x, s2);
            o0 = MFMA32(frag_tr_acc(Vt, TP, 32 * mb + 16 * s2, 32 * (2 * vh), lane), pf, o0);
            o1 = MFMA32(frag_tr_acc(Vt, TP, 32 * mb + 16 * s2, 32 * (2 * vh + 1), lane), pf, o1); }
    }
    f32x16 i0 = {}, i1 = {};
    const bf16_t* st = STB + (size_t)unit * 16384;
#pragma unroll
    for (int s = 0; s < 8; ++s) {
        const bf16x8 a0 = *(const bf16x8*)(st + (size_t)(32 * (2 * vh) + c32) * 128 + 16 * s + 8 * hi), a1 = *(const bf16x8*)(st + (size_t)(32 * (2 * vh + 1) + c32) * 128 + 16 * s + 8 * hi);
        i0 = MFMA32(a0, qf[s], i0); i1 = MFMA32(a1, qf[s], i1);
    }
    const float qdec = __builtin_amdgcn_exp2f((float)(lq + 1) * l2g);
    float s1 = 0.f, s2 = 0.f;
#pragma unroll
    for (int r = 0; r < 16; ++r) { o0[r] += qdec * i0[r]; o1[r] += qdec * i1[r]; s1 += o0[r] + o1[r]; s2 += o0[r] * o0[r] + o1[r] * o1[r]; }
    s1 += __shfl_xor(s1, 32); s2 += __shfl_xor(s2, 32);
    if (hi == 0) { red[(wid * 32 + c32) * 2] = s1; red[(wid * 32 + c32) * 2 + 1] = s2; }
    __syncthreads();
    { const int pw = wid ^ 4; s1 += red[(pw * 32 + c32) * 2]; s2 += red[(pw * 32 + c32) * 2 + 1]; }
    const float mean = s1 * (1.f / 128.f), var = s2 * (1.f / 128.f) - mean * mean, rstd = 1.0f / sqrtf(var + GN_EPS);
    const int row = row0 + lq;
#pragma unroll
    for (int vbi = 0; vbi < 2; ++vbi)
#pragma unroll
        for (int rg = 0; rg < 4; ++rg) {
            const int v0 = 32 * (2 * vh + vbi) + 8 * rg + 4 * hi;
            const f32x4 gn = *(const f32x4*)(gn_g + hh * 128 + v0); const u32x2 gw = *(const u32x2*)(H + (size_t)row * EIN + 2048 + hh * 128 + v0);
            const float gt[4] = {bf_lo(gw.x), bf_hi(gw.x), bf_lo(gw.y), bf_hi(gw.y)}; float y[4];
#pragma unroll
            for (int j = 0; j < 4; ++j) { const float ov = vbi ? o1[4 * rg + j] : o0[4 * rg + j]; y[j] = silu_f(gt[j]) * ((ov - mean) * rstd * gn[j]); }
            u32x2 w; w.x = pk2(y[0], y[1]); w.y = pk2(y[2], y[3]); *(u32x2*)(CAT + (size_t)row * DM + POOLD + hh * 128 + v0) = w;
        }
    __syncthreads();
}

__device__ __forceinline__ void ret_sample_unit(int unit, const float* state_ret, float* outp, const float* gn_g, const bf16_t* H, bf16_t* CAT, LAS unsigned char* lds) {
    const int tid = threadIdx.x, b = unit >> 2, hh = unit & 3; const float l2g = log2gamma(hh);
    LAS float* qs = (LAS float*)lds; LAS float* ks = qs + 512; LAS float* vs = ks + 512; LAS float* A = vs + 512; LAS float* red = A + 16; LAS float* st = red + 2048;
    { const int l = tid >> 7, d = tid & 127; const bf16_t* hr = H + (size_t)(MPR + b * DS + l) * EIN + hh * 128 + d;
        qs[tid] = bf2f(hr[512]); ks[tid] = bf2f(hr[1024]); vs[tid] = bf2f(hr[1536]); }
    __syncthreads();
    if (tid < 16) { const int l = tid >> 2, m = tid & 3; float s = 0.f; for (int d = 0; d < 128; ++d) s += qs[l * 128 + d] * ks[m * 128 + d]; A[tid] = (m <= l) ? s * __builtin_amdgcn_exp2f((float)(l - m) * l2g) : 0.f; }
    const int v = tid & 127, dg = tid >> 7;
    const float g4 = __builtin_amdgcn_exp2f(4.f * l2g), kd0 = __builtin_amdgcn_exp2f(3.f * l2g), kd1 = __builtin_amdgcn_exp2f(2.f * l2g), kd2 = __builtin_amdgcn_exp2f(l2g);
    const float v0 = vs[v] * kd0, v1 = vs[128 + v] * kd1, v2 = vs[256 + v] * kd2, v3 = vs[384 + v];
    const float* S = state_ret + ((size_t)(b * RH + hh) * RD) * RD; float* So = outp + O_RETS + ((size_t)(b * RH + hh) * RD) * RD;
    float p0 = 0.f, p1 = 0.f, p2 = 0.f, p3 = 0.f;
#pragma unroll 4
    for (int i = 0; i < 32; ++i) { const int d = dg * 32 + i; const float sv = S[d * 128 + v];
        So[d * 128 + v] = g4 * sv + ks[d] * v0 + ks[128 + d] * v1 + ks[256 + d] * v2 + ks[384 + d] * v3;
        p0 += qs[d] * sv; p1 += qs[128 + d] * sv; p2 += qs[256 + d] * sv; p3 += qs[384 + d] * sv; }
    red[(dg * 4 + 0) * 128 + v] = p0; red[(dg * 4 + 1) * 128 + v] = p1; red[(dg * 4 + 2) * 128 + v] = p2; red[(dg * 4 + 3) * 128 + v] = p3;
    __syncthreads();
    const int l = tid >> 7;
    float o = (red[(0 * 4 + l) * 128 + v] + red[(1 * 4 + l) * 128 + v] + red[(2 * 4 + l) * 128 + v] + red[(3 * 4 + l) * 128 + v]) * __builtin_amdgcn_exp2f((float)(l + 1) * l2g);
#pragma unroll
    for (int m = 0; m < 4; ++m) o += A[l * 4 + m] * vs[m * 128 + v];
    const float ws1 = wave_sum(o), ws2 = wave_sum(o * o);
    if ((tid & 63) == 0) { st[((tid >> 6)) * 2] = ws1; st[((tid >> 6)) * 2 + 1] = ws2; }
    __syncthreads();
    const int w0 = (tid >> 7) * 2; const float s1 = st[w0 * 2] + st[(w0 + 1) * 2], s2 = st[w0 * 2 + 1] + st[(w0 + 1) * 2 + 1];
    const float mean = s1 * (1.f / 128.f), var = s2 * (1.f / 128.f) - mean * mean, rstd = 1.0f / sqrtf(var + GN_EPS);
    const int row = MPR + b * DS + l; const float gt = bf2f(H[(size_t)row * EIN + 2048 + hh * 128 + v]);
    CAT[(size_t)row * DM + POOLD + hh * 128 + v] = f2bf(silu_f(gt) * ((o - mean) * rstd * gn_g[hh * 128 + v]));
    __syncthreads();
}
__device__ __forceinline__ void mla_norm_pass(const float* q_norm_g, const float* kv_norm_g, float* outp, const float* Z, bf16_t* CQN, bf16_t* CKVN, bf16_t* KF, bf16_t* KPEB, const float* c32t, const float* s32t, int gw, int NGW, int lane) {
    for (int row = gw; row < MV; row += NGW) {
        const float* z = Z + (size_t)row * DM;
        const f32x4 q0 = *(const f32x4*)(z + 4 * lane), q1 = *(const f32x4*)(z + 256 + 4 * lane), kv = *(const f32x4*)(z + 512 + 4 * lane);
        float sq = (q0[0] * q0[0] + q0[1] * q0[1]) + (q0[2] * q0[2] + q0[3] * q0[3]) + (q1[0] * q1[0] + q1[1] * q1[1]) + (q1[2] * q1[2] + q1[3] * q1[3]);
        float sk = (kv[0] * kv[0] + kv[1] * kv[1]) + (kv[2] * kv[2] + kv[3] * kv[3]);
        sq = wave_sum(sq); sk = wave_sum(sk);
        const float rq = 1.0f / sqrtf(sq * (1.f / QL) + RMS_EPS), rk = 1.0f / sqrtf(sk * (1.f / KVL) + RMS_EPS);
        const f32x4 g0 = *(const f32x4*)(q_norm_g + 4 * lane), g1 = *(const f32x4*)(q_norm_g + 256 + 4 * lane), gk = *(const f32x4*)(kv_norm_g + 4 * lane);
        const f32x4 y0 = q0 * rq * g0, y1 = q1 * rq * g1, yk = kv * rk * gk;
        u32x2 w; w.x = pk2(y0[0], y0[1]); w.y = pk2(y0[2], y0[3]); *(u32x2*)(CQN + (size_t)row * QL + 4 * lane) = w;
        w.x = pk2(y1[0], y1[1]); w.y = pk2(y1[2], y1[3]); *(u32x2*)(CQN + (size_t)row * QL + 256 + 4 * lane) = w;
        w.x = pk2(yk[0], yk[1]); w.y = pk2(yk[2], yk[3]); *(u32x2*)(CKVN + (size_t)row * KVL + 4 * lane) = w;
        float* ock = row < MPR ? outp + O_CKVP + (size_t)row * KVL : outp + O_CKVS + (size_t)(row - MPR) * KVL;
        *(f32x4*)(ock + 4 * lane) = yk;
        if (lane < 32) {
            const int tix = row < MPR ? (row & (SEQ - 1)) : SEQ + (row & 3);
            const float x1 = z[768 + lane], x2 = z[800 + lane], c = c32t[tix * 32 + lane], s = s32t[tix * 32 + lane];
            const float y1r = x1 * c - x2 * s, y2r = x2 * c + x1 * s;
            float* okp = row < MPR ? outp + O_KPEP + (size_t)row * ROPE : outp + O_KPES + (size_t)(row - MPR) * ROPE;
            okp[lane] = y1r; okp[32 + lane] = y2r;
            const bf16_t b1 = f2bf(y1r), b2 = f2bf(y2r);
            if (row < MPR) {
#pragma unroll
                for (int h = 0; h < MH; ++h) { bf16_t* p = KF + ((size_t)row * MH + h) * QKD + NOPE; p[lane] = b1; p[32 + lane] = b2; }
            } else { KPEB[(size_t)(row - MPR) * ROPE + lane] = b1; KPEB[(size_t)(row - MPR) * ROPE + 32 + lane] = b2; }
        }
    }
}

constexpr int KP = 400;
constexpr int ATT_STAGE = 64 * KP + 64 * TP;
__device__ __forceinline__ void attn_prompt_unit(int b, int h, int qb, const bf16_t* Q, const bf16_t* KF, const bf16_t* V, bf16_t* O, LAS unsigned char* lds) {
    const int tid = threadIdx.x, lane = tid & 63, wid = tid >> 6, hi = lane >> 5, c32 = lane & 31;
    const int rowb = b * SEQ, q0 = qb * 256, qw = q0 + 32 * wid;
    const int qpos = qw + c32;
    bf16x8 qf[12];
#pragma unroll
    for (int s = 0; s < 12; ++s) qf[s] = *(const bf16x8*)(Q + ((size_t)(rowb + qpos) * MH + h) * QKD + 16 * s + 8 * hi);
    const int NT = (q0 + 256) / 64;
    u32x4 kr[3], vr[2];
    auto gload = [&](int j) {
#pragma unroll
        for (int i = 0; i < 3; ++i) { const int ch = tid + 512 * i, r = ch / 24, cc = ch % 24; kr[i] = *(const u32x4*)(KF + ((size_t)(rowb + 64 * j + r) * MH + h) * QKD + cc * 8); }
#pragma unroll
        for (int i = 0; i < 2; ++i) { const int ch = tid + 512 * i, r = ch >> 4, cc = ch & 15; vr[i] = *(const u32x4*)(V + ((size_t)(rowb + 64 * j + r) * MH + h) * VD + cc * 8); }
    };
    auto swrite = [&](LAS unsigned char* st) {
#pragma unroll
        for (int i = 0; i < 3; ++i) { const int ch = tid + 512 * i, r = ch / 24, cc = ch % 24; *(LAS u32x4*)(st + r * KP + cc * 16) = kr[i]; }
#pragma unroll
        for (int i = 0; i < 2; ++i) { const int ch = tid + 512 * i, r = ch >> 4, cc = ch & 15; *(LAS u32x4*)(st + 64 * KP + r * TP + cc * 16) = vr[i]; }
    };
    f32x16 o[4]; o[0] = f32x16{}; o[1] = f32x16{}; o[2] = f32x16{}; o[3] = f32x16{};
    float mrun = -INFINITY, lrun = 0.f;
    gload(0);
    for (int j = 0; j < NT; ++j) {
        LAS unsigned char* st = lds + (j & 1) * ATT_STAGE;
        swrite(st);
        __syncthreads();
        if (j + 1 < NT) gload(j + 1);
        const LAS unsigned char* Kt = st; const LAS unsigned char* Vt = st + 64 * KP;
#pragma unroll
        for (int half = 0; half < 2; ++half) {
            const int kvh = 64 * j + 32 * half;
            if (kvh <= qw + 31) {
                f32x16 p = {};
#pragma unroll
                for (int sg = 0; sg < 3; ++sg) { bf16x8 kf[4];
#pragma unroll
                    for (int i = 0; i < 4; ++i) kf[i] = frag_row(Kt, KP, 32 * half, 16 * (4 * sg + i), lane);
#pragma unroll
                    for (int i = 0; i < 4; ++i) p = MFMA32(kf[i], qf[4 * sg + i], p);
                    __builtin_amdgcn_sched_barrier(0); }
                if (kvh + 31 > qw) {
#pragma unroll
                    for (int r = 0; r < 16; ++r) { if (kvh + crow(r, hi) > qpos) p[r] = -INFINITY; }
                }
                float mx = p[0];
#pragma unroll
                for (int r = 1; r < 16; ++r) mx = fmaxf(mx, p[r]);
                mx = fmaxf(mx, __shfl_xor(mx, 32));
                const float mnew = fmaxf(mrun, mx), alpha = __builtin_amdgcn_exp2f(mrun - mnew);
                float ps = 0.f;
#pragma unroll
                for (int r = 0; r < 16; ++r) { p[r] = __builtin_amdgcn_exp2f(p[r] - mnew); ps += p[r]; }
                lrun = lrun * alpha + ps; mrun = mnew;
                if (__any(alpha != 1.0f)) {
#pragma unroll
                    for (int cb = 0; cb < 4; ++cb)
#pragma unroll
                        for (int r = 0; r < 16; ++r) o[cb][r] *= alpha;
                }
                const bf16x8 pf0 = acc_frag(p, 0), pf1 = acc_frag(p, 1);
#pragma unroll
                for (int cb = 0; cb < 4; ++cb) {
                    const bf16x8 v0 = frag_tr_acc(Vt, TP, 32 * half, 32 * cb, lane), v1 = frag_tr_acc(Vt, TP, 32 * half + 16, 32 * cb, lane);
                    o[cb] = MFMA32(v0, pf0, o[cb]); o[cb] = MFMA32(v1, pf1, o[cb]);
                    if (cb & 1) __builtin_amdgcn_sched_barrier(0);
                }
            }
        }
    }
    lrun += __shfl_xor(lrun, 32);
    const float inv = 1.0f / lrun;
    bf16_t* orow = O + (size_t)(rowb + qpos) * DM + h * VD;
#pragma unroll
    for (int cb = 0; cb < 4; ++cb)
#pragma unroll
        for (int rg = 0; rg < 4; ++rg) { u32x2 w; w.x = pk2(o[cb][4 * rg] * inv, o[cb][4 * rg + 1] * inv); w.y = pk2(o[cb][4 * rg + 2] * inv, o[cb][4 * rg + 3] * inv);
            *(u32x2*)(orow + 32 * cb + 8 * rg + 4 * hi) = w; }
    __syncthreads();
}

constexpr int SP = 672;
constexpr int PART_LD = 264;
__device__ __forceinline__ void attn_sample_unit(int b, int sp, const int* page_table, const float* cache_ckv, const float* cache_kpe, const bf16_t* Q, const bf16_t* WUKB, float* PART, bf16_t* QLAT, LAS unsigned char* lds) {
    const int tid = threadIdx.x, lane = tid & 63, wid = tid >> 6, hi = lane >> 5, c32 = lane & 31;
    LAS unsigned char* KT0 = lds; LAS unsigned char* QT = lds + 64 * SP;
    {
        const int h = wid;
        bf16x8 bq[8];
#pragma unroll
        for (int s = 0; s < 8; ++s) { bf16x8 z = {}; if (c32 < DS) z = *(const bf16x8*)(Q + ((size_t)(MPR + b * DS + c32) * MH + h) * QKD + 16 * s + 8 * hi); bq[s] = z; }
        for (int ct = 0; ct < 8; ++ct) {
            f32x16 acc = {};
#pragma unroll
            for (int s = 0; s < 8; ++s) { const bf16x8 af = *(const bf16x8*)(WUKB + (size_t)(32 * ct + c32) * 1024 + h * 128 + 16 * s + 8 * hi); acc = MFMA32(af, bq[s], acc); }
            if (c32 < DS) {
#pragma unroll
                for (int rg = 0; rg < 4; ++rg) { u32x2 w; w.x = pk2(acc[4 * rg], acc[4 * rg + 1]); w.y = pk2(acc[4 * rg + 2], acc[4 * rg + 3]);
                    *(LAS u32x2*)(QT + (c32 * 8 + h) * SP + (32 * ct + 8 * rg + 4 * hi) * 2) = w; }
            }
        }
        if (tid < 256) { const int r = tid >> 3, cc = tid & 7, q = r >> 3, hh = r & 7;
            *(LAS u32x4*)(QT + r * SP + 512 + cc * 16) = *(const u32x4*)(Q + ((size_t)(MPR + b * DS + q) * MH + hh) * QKD + NOPE + cc * 8); }
    }
    __syncthreads();
    if (sp == 0) {
        for (int i = tid; i < 32 * 40; i += 512) { const int r = i / 40, cc = i % 40; *(u32x4*)(QLAT + ((size_t)b * 32 + r) * 320 + cc * 8) = *(const LAS u32x4*)(QT + r * SP + cc * 16); }
    }
    f32x16 o = {};
    float mrun = -INFINITY, lrun = 0.f;
    f32x4 cr[4], pr;
#define SA_GLOAD(t) do { const int pid_ = page_table[b * NPG + sp * 16 + ((t) >> 2)]; \
        const f32x4* cp_ = (const f32x4*)(cache_ckv + ((size_t)pid_ * PAGE + ((t) & 3) * 32) * KVL); const f32x4* pp_ = (const f32x4*)(cache_kpe + ((size_t)pid_ * PAGE + ((t) & 3) * 32) * ROPE); \
        _Pragma("unroll") for (int i = 0; i < 4; ++i) cr[i] = __builtin_nontemporal_load(cp_ + tid + 512 * i); \
        pr = __builtin_nontemporal_load(pp_ + tid); } while (0)
    SA_GLOAD(0);
    for (int t = 0; t < 64; ++t) {
        LAS unsigned char* KT = KT0 + (t & 1) * (32 * SP);
#pragma unroll
        for (int i = 0; i < 4; ++i) { const int f = tid + 512 * i, key = f >> 6, c4 = f & 63; u32x2 w; w.x = pk2(cr[i][0], cr[i][1]); w.y = pk2(cr[i][2], cr[i][3]); *(LAS u32x2*)(KT + key * SP + c4 * 8) = w; }
        { const int key = tid >> 4, c4 = tid & 15; u32x2 w; w.x = pk2(pr[0], pr[1]); w.y = pk2(pr[2], pr[3]); *(LAS u32x2*)(KT + key * SP + 512 + c4 * 8) = w; }
        __syncthreads();
        if (t + 1 < 64) SA_GLOAD(t + 1);
        f32x16 x = {};
#pragma unroll
        for (int sg = 0; sg < 5; ++sg) { bf16x8 kf[4], qq[4];
#pragma unroll
            for (int i = 0; i < 4; ++i) { kf[i] = frag_row(KT, SP, 0, 16 * (4 * sg + i), lane); qq[i] = frag_row(QT, SP, 0, 16 * (4 * sg + i), lane); }
#pragma unroll
            for (int i = 0; i < 4; ++i) x = MFMA32(kf[i], qq[i], x);
            __builtin_amdgcn_sched_barrier(0); }
        float mx = x[0];
#pragma unroll
        for (int r = 1; r < 16; ++r) mx = fmaxf(mx, x[r]);
        mx = fmaxf(mx, __shfl_xor(mx, 32));
        const float mnew = fmaxf(mrun, mx), alpha = __builtin_amdgcn_exp2f(mrun - mnew);
        float ps = 0.f;
#pragma unroll
        for (int r = 0; r < 16; ++r) { x[r] = __builtin_amdgcn_exp2f(x[r] - mnew); ps += x[r]; }
        lrun = lrun * alpha + ps; mrun = mnew;
        const bf16x8 pf0 = acc_frag(x, 0), pf1 = acc_frag(x, 1);
#pragma unroll
        for (int r = 0; r < 16; ++r) o[r] *= alpha;
        o = MFMA32(frag_tr_acc(KT, SP, 0, 32 * wid, lane), pf0, o);
        o = MFMA32(frag_tr_acc(KT, SP, 16, 32 * wid, lane), pf1, o);
    }
#undef SA_GLOAD
    lrun += __shfl_xor(lrun, 32);
    float* pp = PART + ((size_t)(b * 8 + sp) * 32) * PART_LD;
#pragma unroll
    for (int r = 0; r < 16; ++r) pp[(size_t)c32 * PART_LD + 32 * wid + crow(r, hi)] = o[r];
    if (wid == 0 && hi == 0) { pp[(size_t)c32 * PART_LD + 256] = mrun; pp[(size_t)c32 * PART_LD + 257] = lrun; }
    __syncthreads();
}

__device__ __forceinline__ void attn_combine_unit(int b, int q, const float* w_uv, const float* PART, const bf16_t* QLAT, const bf16_t* CKVN, const bf16_t* KPEB, bf16_t* O, LAS unsigned char* lds) {
    const int tid = threadIdx.x, lane = tid & 63, h = tid >> 6;
    LAS float* SN = (LAS float*)lds;
    LAS float* OL = SN + 32;
    const int r = q * 8 + h;
    {
        const int kp = lane >> 4, li = lane & 15; float s = 0.f;
        const bf16_t* ql = QLAT + ((size_t)b * 32 + r) * 320; const bf16_t* ck = CKVN + (size_t)(MPR + b * DS + kp) * KVL; const bf16_t* kpe = KPEB + (size_t)(b * DS + kp) * ROPE;
        for (int i = 0; i < 16; ++i) { const int c = li + 16 * i; s += bf2f(ql[c]) * bf2f(ck[c]); }
        for (int i = 0; i < 4; ++i) { const int c = li + 16 * i; s += bf2f(ql[256 + c]) * bf2f(kpe[c]); }
#pragma unroll
        for (int o = 1; o < 16; o <<= 1) s += __shfl_xor(s, o);
        if (li == 0) SN[h * 4 + kp] = (kp <= q) ? s : -INFINITY;
    }
    __syncthreads();
    float ms[8], ls[8], M = -INFINITY;
#pragma unroll
    for (int s = 0; s < 8; ++s) { const float* pp = PART + ((size_t)(b * 8 + s) * 32 + r) * PART_LD; ms[s] = pp[256]; ls[s] = pp[257]; M = fmaxf(M, ms[s]); }
    float sn[4];
#pragma unroll
    for (int k = 0; k < 4; ++k) { sn[k] = SN[h * 4 + k]; M = fmaxf(M, sn[k]); }
    float L = 0.f, wn[4], wsp[8];
#pragma unroll
    for (int s = 0; s < 8; ++s) { wsp[s] = __builtin_amdgcn_exp2f(ms[s] - M); L += ls[s] * wsp[s]; }
#pragma unroll
    for (int k = 0; k < 4; ++k) { wn[k] = __builtin_amdgcn_exp2f(sn[k] - M); L += wn[k]; }
    const float invL = 1.0f / L;
#pragma unroll
    for (int i = 0; i < 4; ++i) { const int c = lane + 64 * i; float acc = 0.f;
#pragma unroll
        for (int s = 0; s < 8; ++s) acc += wsp[s] * PART[((size_t)(b * 8 + s) * 32 + r) * PART_LD + c];
#pragma unroll
        for (int k = 0; k < 4; ++k) acc += wn[k] * bf2f(CKVN[(size_t)(MPR + b * DS + k) * KVL + c]);
        OL[h * 256 + c] = acc * invL; }
    __syncthreads();
    float o0 = 0.f, o1 = 0.f; const float* wv = w_uv + h * 128 + lane;
#pragma unroll 4
    for (int c = 0; c < 256; ++c) { const float ol = OL[h * 256 + c]; o0 += ol * wv[(size_t)c * 1024]; o1 += ol * wv[(size_t)c * 1024 + 64]; }
    bf16_t* orow = O + (size_t)(MPR + b * DS + q) * DM + h * 128;
    orow[lane] = f2bf(o0); orow[lane + 64] = f2bf(o1);
    __syncthreads();
}
constexpr int LDS_BYTES = 147456;
constexpr size_t WS_WUKB = WS_END;
constexpr size_t WS_TOTAL = WS_WUKB + (size_t)KVL * 1024 * 2;

#define XB_TMO      128
#define XB_XCNT(j)  (256  + 64 * (j))
#define XB_XSUB(j)  (1280 + 64 * (j))
#define XB_XGEN(j)  (2304 + 64 * (j))
#define XB_TOP      3328
#define XB_TOPGEN   3392
#define XCD_BAR_WORDS 3456
#define XB_SPIN_CAP (1u << 18)
__device__ __forceinline__ unsigned xb_ld(unsigned* p)              { return __hip_atomic_load(p, __ATOMIC_RELAXED, __HIP_MEMORY_SCOPE_AGENT); }
__device__ __forceinline__ unsigned xb_add(unsigned* p, unsigned v) { return __hip_atomic_fetch_add(p, v, __ATOMIC_RELAXED, __HIP_MEMORY_SCOPE_AGENT); }
__device__ __forceinline__ unsigned xb_xcc_id() { return (unsigned)__builtin_amdgcn_s_getreg((3 << 11) | 20) & 0xFu; }
#define XB_SPIN(cond, bar) do { unsigned _sp = 0; while (cond) { __builtin_amdgcn_s_sleep(1); \
    if ((++_sp & 255u) == 0u) { if (xb_ld(&(bar)[XB_TMO])) break; if (_sp > XB_SPIN_CAP) { atomicAdd(&(bar)[XB_TMO], 1u); break; } } } } while (0)
struct XcdBarrier { unsigned* bar; unsigned x; volatile LAS unsigned* st; };
__device__ __forceinline__ XcdBarrier xcd_barrier_post(unsigned* bar, volatile LAS unsigned* st) {
    XcdBarrier b; b.bar = bar; b.x = xb_xcc_id(); b.st = st;
    if (threadIdx.x == 0) (void)xb_add(&bar[XB_XCNT(b.x)], 1u);
    return b;
}
__device__ __forceinline__ void xcd_barrier_complete(unsigned* bar, unsigned x, unsigned& nloc, unsigned& nx) {
    const unsigned G = gridDim.x * gridDim.y * gridDim.z;
    unsigned sum, cnt, mine, sp = 0u;
    for (;;) {
        sum = 0u; cnt = 0u; mine = 0u;
#pragma unroll
        for (unsigned j = 0; j < 16; ++j) { const unsigned c = xb_ld(&bar[XB_XCNT(j)]); sum += c; cnt += (c > 0u) ? 1u : 0u; mine = (j == x) ? c : mine; }
        if (sum == G) break;
        __builtin_amdgcn_s_sleep(1);
        if ((++sp & 255u) == 0u) { if (xb_ld(&bar[XB_TMO])) break; if (sp > XB_SPIN_CAP) { atomicAdd(&bar[XB_TMO], 1u); break; } }
    }
    nloc = mine > 0u ? mine : 1u; nx = cnt > 0u ? cnt : 1u;
}
__device__ __forceinline__ void xcd_barrier(const XcdBarrier& b) {
    asm volatile("s_waitcnt vmcnt(0)" ::: "memory");
    __syncthreads();
    if (threadIdx.x == 0) {
        unsigned* bar = b.bar;
        __builtin_amdgcn_s_waitcnt(0);
        unsigned nloc = b.st[0], nx = b.st[1];
        if (nloc == 0u) { xcd_barrier_complete(bar, b.x, nloc, nx); b.st[0] = nloc; b.st[1] = nx; }
        const unsigned old = xb_add(&bar[XB_XSUB(b.x)], 1u);
        const unsigned gen = old / nloc;
        if (old + 1u == (gen + 1u) * nloc) {
            __builtin_amdgcn_fence(__ATOMIC_RELEASE, "agent");
            asm volatile("s_waitcnt vmcnt(0)" ::: "memory");
            const unsigned og = xb_add(&bar[XB_TOP], 1u);
            const unsigned tg = og / nx;
            if (og + 1u == (tg + 1u) * nx) xb_add(&bar[XB_TOPGEN], 1u);
            else XB_SPIN(xb_ld(&bar[XB_TOPGEN]) == tg, bar);
            __builtin_amdgcn_fence(__ATOMIC_ACQUIRE, "agent");
            xb_add(&bar[XB_XGEN(b.x)], 1u);
            asm volatile("s_waitcnt vmcnt(0)" ::: "memory");
        } else {
            XB_SPIN(xb_ld(&bar[XB_XGEN(b.x)]) == gen, bar);
            __builtin_amdgcn_fence(__ATOMIC_ACQUIRE, "agent");
            asm volatile("s_waitcnt vmcnt(0)" ::: "memory");
        }
    }
    __syncthreads();
}

constexpr int BARST_OFF = 131072;
constexpr int ARGS_OFF = 131072 + 256;

__global__ void __launch_bounds__(512, 2) fwd_kernel(Args a) {
    extern __shared__ __attribute__((aligned(16))) unsigned char lds_raw[];
    LAS unsigned char* lds = (LAS unsigned char*)lds_raw;
    const int tid = threadIdx.x, lane = tid & 63, wave = tid >> 6, G = gridDim.x, bx = blockIdx.x;
    const int gw = bx * 8 + wave, NGW = G * 8, gtid = bx * 512 + tid, gsz = G * 512;
    const int lo = a.ph_lo, hi = a.ph_hi;
    LAS unsigned* sa = (LAS unsigned*)(lds + ARGS_OFF);
    if (tid == 0) {
        LAS unsigned long long* sp = (LAS unsigned long long*)sa;
#define X(T, n) sp[AI_##n] = (unsigned long long)a.n;
        ARG_LIST(X)
#undef X
    }
    if (tid == 0) { ((volatile LAS unsigned*)(lds + BARST_OFF))[0] = 0u; ((volatile LAS unsigned*)(lds + BARST_OFF))[1] = 0u; }
    __syncthreads();
    XcdBarrier xbar = xcd_barrier_post((unsigned*)(a.ws + WS_CTL), (volatile LAS unsigned*)(lds + BARST_OFF));
#define LP(n) ldarg<decltype(Args::n)>(sa, AI_##n)
#define WSP(T, off) ((T*)(LP(ws) + (off)))
#ifndef PH_MASK
#define PH_MASK 0xffffffffu
#endif
#define IN(k) (((PH_MASK >> (k)) & 1u) && lo <= (k) && (k) < hi)
#ifndef REP_MASK
#define REP_MASK 0u
#endif
#define REPS(k) for (int rep_ = 0; rep_ < 1 + (int)((REP_MASK >> (k)) & 1u); ++rep_)
#ifdef REP_SYNC
#define SEAM(k) do { if (IN(k) && IN((k) + 1)) { xcd_barrier(xbar); xcd_barrier(xbar); } } while (0)
#else
#define SEAM(k) do { if (IN(k) && IN((k) + 1)) xcd_barrier(xbar); } while (0)
#endif
#define GEMM(Aptr, lda_, Bptr, ldb_, N_, K_, EPI) do { int k_ = K_; asm volatile("" : "+s"(k_)); pg8::Gemm g_{Aptr, Bptr, lda_, ldb_, MP, N_, k_}; pg8::StaticOrder S_; S_.init(MP, N_, G, bx); pg8::gemm_phase(lds, g_, S_, EPI); } while (0)
#define TABS float* c64 = WSP(float, WS_TAB); float* s64 = c64 + NPOS * 64; float* c32t = s64 + NPOS * 64; float* s32t = c32t + NPOS * 32

    if (IN(0)) REPS(0) {
        p0_prologue(a, lds, gw, NGW, lane, gtid, gsz);
        bf16_t* WUKB = WSP(bf16_t, WS_WUKB);
        for (int e = gtid; e < KVL * 1024 / 4; e += gsz) { const f32x4 v = *((const f32x4*)a.w_uk + e); u32x2 w; w.x = pk2(v[0], v[1]); w.y = pk2(v[2], v[3]); *((u32x2*)WUKB + e) = w; }
    }
    SEAM(0);
    if (IN(1)) REPS(1) { TABS; (void)c32t; (void)s32t; epi::EpiIn E{WSP(bf16_t, WS_H), c64, s64}; GEMM(WSP(bf16_t, WS_X0), DM, WSP(bf16_t, WS_WIN), DM, EIN, DM, E); }
    SEAM(1);
    if (IN(2)) REPS(2) {
        const bf16_t* H = WSP(bf16_t, WS_H); bf16_t* CAT = WSP(bf16_t, WS_CAT);
        pool_pass(LP(state_pool), LP(out), H, CAT, gtid, gsz);
        float* KVLOC = WSP(float, WS_KVLOC);
        for (int u = bx; u < 512; u += G) ret_r1_unit(u, H, KVLOC, lds);
        for (int u = G - 1 - bx; u < 128; u += G) ret_sample_unit(u, LP(state_ret), LP(out), LP(gn_g), H, CAT, lds);
    }
    SEAM(2);
    if (IN(3)) REPS(3) ret_scan_pass(WSP(float, WS_KVLOC), WSP(bf16_t, WS_STB), LP(out) + O_RETP, gtid, gsz);
    SEAM(3);
    if (IN(4)) REPS(4) { const float* gn = LP(gn_g); const bf16_t* H = WSP(bf16_t, WS_H); const bf16_t* STB = WSP(bf16_t, WS_STB); bf16_t* CAT = WSP(bf16_t, WS_CAT);
        for (int u = bx; u < 512; u += G) ret_r3_unit(u, gn, H, STB, CAT, lds); }
    SEAM(4);
    if (IN(5)) REPS(5) { epi::EpiZ E{WSP(float, WS_Z), DM, WSP(bf16_t, WS_X0), DM, ALPHA}; GEMM(WSP(bf16_t, WS_CAT), DM, WSP(bf16_t, WS_WCAT), DM, DM, DM, E); }
    SEAM(5);
    if (IN(6)) REPS(6) ln_pass(WSP(float, WS_Z), LP(ln_mix_g), LP(ln_mix_b), WSP(bf16_t, WS_X1), nullptr, nullptr, gw, NGW, lane);
    SEAM(6);
    if (IN(7)) REPS(7) { float* o = LP(out); epi::EpiUp E{WSP(bf16_t, WS_AB), WSP(bf16_t, WS_BB), o + O_CONVP, o + O_CONVS}; GEMM(WSP(bf16_t, WS_X1), DM, WSP(bf16_t, WS_WUP0), DM, 2 * FF, DM, E); }
    SEAM(7);
    if (IN(8)) REPS(8) conv_gate_pass(WSP(bf16_t, WS_AB), WSP(bf16_t, WS_BB), WSP(bf16_t, WS_G), LP(conv_w), LP(conv_b), LP(state_conv), gtid, gsz);
    SEAM(8);
    if (IN(9)) REPS(9) { epi::EpiZ E{WSP(float, WS_Z), DM, WSP(bf16_t, WS_X1), DM, ALPHA}; GEMM(WSP(bf16_t, WS_G), FF, WSP(bf16_t, WS_WDN0), FF, DM, FF, E); }
    SEAM(9);
    if (IN(10)) REPS(10) ln_pass(WSP(float, WS_Z), LP(ln_ffn_g), LP(ln_ffn_b), WSP(bf16_t, WS_X0), nullptr, nullptr, gw, NGW, lane);
    SEAM(10);
    if (IN(11)) REPS(11) { epi::EpiZ E{WSP(float, WS_Z), DM, nullptr, 0, 0.f}; GEMM(WSP(bf16_t, WS_X0), DM, WSP(bf16_t, WS_WDQKV), DM, DM, DM, E); }
    SEAM(11);
    if (IN(12)) REPS(12) { TABS; (void)c64; (void)s64; mla_norm_pass(LP(q_norm_g), LP(kv_norm_g), LP(out), WSP(float, WS_Z), WSP(bf16_t, WS_CQN), WSP(bf16_t, WS_CKVN), WSP(bf16_t, WS_KF), WSP(bf16_t, WS_KPEB), c32t, s32t, gw, NGW, lane); }
    SEAM(12);
    if (IN(13)) REPS(13) {
#if !defined(G13_ONLY) || G13_ONLY == 1
        { TABS; (void)c64; (void)s64; epi::EpiUq E{WSP(bf16_t, WS_Q), c32t, s32t}; GEMM(WSP(bf16_t, WS_CQN), QL, WSP(bf16_t, WS_WUQ), QL, 1536, QL, E); }
#endif
#if !defined(G13_ONLY) || G13_ONLY == 2
        { epi::EpiUkv E{WSP(bf16_t, WS_KF), WSP(bf16_t, WS_V)}; GEMM(WSP(bf16_t, WS_CKVN), KVL, WSP(bf16_t, WS_WUKV), KVL, 2048, KVL, E); }
#endif
    }
    SEAM(13);
    if (IN(14)) REPS(14) {
        const bf16_t* Q = WSP(bf16_t, WS_Q);
#if !defined(ATT_ONLY) || ATT_ONLY == 1
        { const bf16_t* KF = WSP(bf16_t, WS_KF); const bf16_t* V = WSP(bf16_t, WS_V); bf16_t* O = WSP(bf16_t, WS_CAT);
#ifdef REP_ATTP
        for (int rp_ = 0; rp_ < 2; ++rp_)
#endif
        for (int u = bx; u < 256; u += G) { const int bh = u >> 2, pi = u & 3; attn_prompt_unit(bh >> 3, bh & 7, 7 - pi, Q, KF, V, O, lds); attn_prompt_unit(bh >> 3, bh & 7, pi, Q, KF, V, O, lds); } }
#endif
#if !defined(ATT_ONLY) || ATT_ONLY == 2
        { const int* pt = LP(page_table); const float* cck = LP(cache_ckv); const float* ckp = LP(cache_kpe); const bf16_t* WUKB = WSP(bf16_t, WS_WUKB); float* PART = WSP(float, WS_PART); bf16_t* QLAT = WSP(bf16_t, WS_QLAT);
#ifdef REP_ATTS
        for (int rp_ = 0; rp_ < 2; ++rp_)
#endif
        for (int u = bx; u < 256; u += G) attn_sample_unit(u >> 3, u & 7, pt, cck, ckp, Q, WUKB, PART, QLAT, lds); }
#endif
    }
    SEAM(14);
    if (IN(15)) REPS(15) { const float* wuv = LP(w_uv); const float* PART = WSP(float, WS_PART); const bf16_t* QLAT = WSP(bf16_t, WS_QLAT); const bf16_t* CKVN = WSP(bf16_t, WS_CKVN); const bf16_t* KPEB = WSP(bf16_t, WS_KPEB); bf16_t* O = WSP(bf16_t, WS_CAT);
        for (int u = bx; u < 128; u += G) attn_combine_unit(u >> 2, u & 3, wuv, PART, QLAT, CKVN, KPEB, O, lds); }
    SEAM(15);
    if (IN(16)) REPS(16) { epi::EpiZ E{WSP(float, WS_Z), DM, WSP(bf16_t, WS_X0), DM, ALPHA}; GEMM(WSP(bf16_t, WS_CAT), DM, WSP(bf16_t, WS_WOM), DM, DM, DM, E); }
    SEAM(16);
    if (IN(17)) REPS(17) ln_pass(WSP(float, WS_Z), LP(ln_mix_g) + DM, LP(ln_mix_b) + DM, WSP(bf16_t, WS_X1), nullptr, nullptr, gw, NGW, lane);
    SEAM(17);
    if (IN(18)) REPS(18) { float* o = LP(out); epi::EpiUp E{WSP(bf16_t, WS_AB), WSP(bf16_t, WS_BB), o + O_CONVP + (size_t)NB * 2 * FF, o + O_CONVS + (size_t)DB * 2 * FF}; GEMM(WSP(bf16_t, WS_X1), DM, WSP(bf16_t, WS_WUP1), DM, 2 * FF, DM, E); }
    SEAM(18);
    if (IN(19)) REPS(19) conv_gate_pass(WSP(bf16_t, WS_AB), WSP(bf16_t, WS_BB), WSP(bf16_t, WS_G), LP(conv_w) + 3 * FF, LP(conv_b) + FF, LP(state_conv) + (size_t)DB * 2 * FF, gtid, gsz);
    SEAM(19);
    if (IN(20)) REPS(20) { epi::EpiZ E{WSP(float, WS_Z), DM, WSP(bf16_t, WS_X1), DM, ALPHA}; GEMM(WSP(bf16_t, WS_G), FF, WSP(bf16_t, WS_WDN1), FF, DM, FF, E); }
    SEAM(20);
    if (IN(21)) REPS(21) { float* o = LP(out); ln_pass(WSP(float, WS_Z), LP(ln_ffn_g) + DM, LP(ln_ffn_b) + DM, nullptr, o + O_YP, o + O_YS, gw, NGW, lane); }
#undef IN
#undef SEAM
#undef GEMM
#undef LP
#undef WSP
#undef TABS
}

constexpr int N_PHASES = 22;
#ifndef MK_SPLIT
#define MK_SPLIT 0
#endif

extern "C" void kernel_launch(void* const* d_in, const int* in_sizes, int n_in, void* d_out, int out_size, void* d_ws, size_t ws_size, hipStream_t stream) {
    static int grid = 0;
    if (grid == 0) {
        int dev = 0, cus = 0, per_cu = 0;
        (void)hipGetDevice(&dev);
        (void)hipDeviceGetAttribute(&cus, hipDeviceAttributeMultiprocessorCount, dev);
        (void)hipFuncSetAttribute((const void*)fwd_kernel, hipFuncAttributeMaxDynamicSharedMemorySize, LDS_BYTES);
        (void)hipOccupancyMaxActiveBlocksPerMultiprocessor(&per_cu, (const void*)fwd_kernel, 512, LDS_BYTES);
        if (n_in != 29 || (size_t)out_size != O_END || ws_size < WS_TOTAL) fprintf(stderr, "kernel_launch: unexpected sizes n_in %d out %d (want %zu) ws %zu (want %zu)\n", n_in, out_size, (size_t)O_END, ws_size, (size_t)WS_TOTAL);
        if (per_cu < 1) { fprintf(stderr, "kernel_launch: occupancy query says %d blocks/CU\n", per_cu); per_cu = 1; }
        grid = cus;
        (void)hipGetLastError();
    }
    Args a{};
    a.x_prompt = (const float*)d_in[0]; a.x_sample = (const float*)d_in[1]; a.state_pool = (const float*)d_in[2]; a.state_ret = (const float*)d_in[3];
    a.cache_ckv = (const float*)d_in[4]; a.cache_kpe = (const float*)d_in[5]; a.state_conv = (const float*)d_in[6]; a.page_table = (const int*)d_in[7];
    a.w_in = (const float*)d_in[8]; a.pool_w = (const float*)d_in[9]; a.pool_scale = (const float*)d_in[10]; a.gn_g = (const float*)d_in[11]; a.w_o_even = (const float*)d_in[12];
    a.w_dq = (const float*)d_in[13]; a.q_norm_g = (const float*)d_in[14]; a.w_uq = (const float*)d_in[15]; a.w_dkv = (const float*)d_in[16]; a.kv_norm_g = (const float*)d_in[17];
    a.w_uk = (const float*)d_in[18]; a.w_uv = (const float*)d_in[19]; a.w_o_mla = (const float*)d_in[20]; a.w_up = (const float*)d_in[21]; a.conv_w = (const float*)d_in[22];
    a.conv_b = (const float*)d_in[23]; a.w_down = (const float*)d_in[24]; a.ln_mix_g = (const float*)d_in[25]; a.ln_mix_b = (const float*)d_in[26]; a.ln_ffn_g = (const float*)d_in[27]; a.ln_ffn_b = (const float*)d_in[28];
    a.out = (float*)d_out; a.ws = (unsigned char*)d_ws; a.dbg = 0; a.pad = 0;
    (void)hipMemsetAsync((char*)d_ws + WS_CTL, 0, 16384, stream);
#if MK_SPLIT
    for (int p = 0; p < N_PHASES; ++p) { a.ph_lo = p; a.ph_hi = p + 1; void* args[] = {&a};
        hipError_t e = hipLaunchCooperativeKernel((const void*)fwd_kernel, dim3(grid), dim3(512), args, LDS_BYTES, stream);
        if (e != hipSuccess) { fprintf(stderr, "launch %d failed: %s\n", p, hipGetErrorString(e)); break; } }
#else
    a.ph_lo = 0; a.ph_hi = N_PHASES; void* args[] = {&a};
    hipError_t e = hipLaunchCooperativeKernel((const void*)fwd_kernel, dim3(grid), dim3(512), args, LDS_BYTES, stream);
    if (e != hipSuccess) fprintf(stderr, "cooperative launch failed: %s (grid %d)\n", hipGetErrorString(e), grid);
#endif
}
```
